# Optimizing an MI355X kernel written in HIP

```python
import math
import jax, jax.numpy as jnp
from jax import lax
import numpy as np

D_MODEL = 2048
BATCH = 4
SEQ = 2048
DEPTH = 1

CHUNK = 64
Q_BLOCK = 128
HEAD_DIM = 128
SB_HEADS = 8
RET_HEADS = 8
SB_WIDTH = SB_HEADS * HEAD_DIM
RET_WIDTH = RET_HEADS * HEAD_DIM
MIX_WIDTH = SB_WIDTH + RET_WIDTH
IN_WIDTH = 3 * SB_WIDTH + 4 * RET_WIDTH
ROPE_BASE = 10000.0
N_EXPERTS = 32
TOP_K = 4
D_FF = D_MODEL
SWIGLU_LIMIT = 7.0
SWIGLU_ALPHA = 1.702
MOE_BLOCK = 128
LN_EPS = 1e-5
GN_EPS = 1e-5
DEEPNORM_ALPHA = (2 * DEPTH) ** 0.25
DEEPNORM_BETA = (8 * DEPTH) ** -0.25

kernel_name = "hybrid_stickbreak_retention_moe_deepnorm"


def layer_norm(x, gain, bias):
    xf = x.astype(jnp.float32)
    mu = jnp.mean(xf, axis=-1, keepdims=True)
    var = jnp.mean(jnp.square(xf - mu), axis=-1, keepdims=True)
    y = (xf - mu) * lax.rsqrt(var + LN_EPS)
    return (y * gain.astype(jnp.float32) + bias.astype(jnp.float32)).astype(x.dtype)


def rotary(x):
    s, d = x.shape[1], x.shape[3]
    inv_freq = ROPE_BASE ** (-jnp.arange(0, d, 2, dtype=jnp.float32) / d)
    ang = jnp.arange(s, dtype=jnp.float32)[:, None] * inv_freq[None, :]
    cos = jnp.cos(ang)[None, :, None, :]
    sin = jnp.sin(ang)[None, :, None, :]
    xf = x.astype(jnp.float32)
    x1, x2 = xf[..., : d // 2], xf[..., d // 2:]
    return jnp.concatenate([x1 * cos - x2 * sin, x1 * sin + x2 * cos], axis=-1).astype(x.dtype)


def stick_breaking_attention(q, k, v):
    b, h, s, d = q.shape
    nq = s // Q_BLOCK
    q_blocks = q.reshape(b, h, nq, Q_BLOCK, d).transpose(2, 0, 1, 3, 4)
    starts = jnp.arange(nq, dtype=jnp.int32) * Q_BLOCK
    kf = k.astype(jnp.float32)
    vf = v.astype(jnp.float32)
    key_pos = jnp.arange(s, dtype=jnp.int32)
    scale = 1.0 / math.sqrt(d)

    def one_block(args):
        q_blk, start = args
        z = jnp.einsum('bhqd,bhkd->bhqk', q_blk.astype(jnp.float32), kf) * scale
        q_pos = start + jnp.arange(Q_BLOCK, dtype=jnp.int32)
        mask = key_pos[None, :] < q_pos[:, None]
        log_not_beta = jnp.where(mask, jax.nn.log_sigmoid(-z), 0.0)
        later = lax.cumsum(log_not_beta, axis=3, reverse=True) - log_not_beta
        weights = jnp.where(mask, jnp.exp(jax.nn.log_sigmoid(z) + later), 0.0)
        return jnp.einsum('bhqk,bhkd->bhqd', weights, vf)

    o = lax.map(one_block, (q_blocks, starts))
    return o.transpose(1, 0, 3, 2, 4).reshape(b, s, h * d).astype(q.dtype)


def chunk_retention(q, k, v, gn_gain):
    b, s, h, d = q.shape
    n = s // CHUNK
    log_gamma = jnp.log1p(-jnp.exp2(-5.0 - jnp.arange(h, dtype=jnp.float32)))
    to_chunks = lambda a: a.astype(jnp.float32).reshape(b, n, CHUNK, h, d).transpose(0, 3, 1, 2, 4)
    qf = to_chunks(q)
    kf = to_chunks(k) * (d ** -0.5)
    vf = to_chunks(v)
    i = jnp.arange(CHUNK, dtype=jnp.float32)
    intra_decay = jnp.exp(log_gamma[:, None, None] * jnp.abs(i[:, None] - i[None, :]))
    scores = jnp.einsum('bhncd,bhnjd->bhncj', qf, kf) * intra_decay[:, None]
    o_intra = jnp.einsum('bhncj,bhnje->bhnce', scores, vf)
    k_decay = jnp.exp(log_gamma[:, None] * (CHUNK - 1 - i))
    chunk_kv = jnp.einsum('bhnjd,bhnje->nbhde', kf * k_decay[:, None, :, None], vf)
    chunk_decay = jnp.exp(log_gamma * CHUNK)[None, :, None, None]

    def step(state, kv):
        return state * chunk_decay + kv, state

    _, prev_states = lax.scan(step, jnp.zeros((b, h, d, d), jnp.float32), chunk_kv)
    q_decay = jnp.exp(log_gamma[:, None] * (i + 1.0))
    o_cross = jnp.einsum('bhncd,nbhde->bhnce', qf * q_decay[:, None, :, None], prev_states)
    o = o_intra + o_cross
    mu = jnp.mean(o, axis=-1, keepdims=True)
    var = jnp.mean(jnp.square(o - mu), axis=-1, keepdims=True)
    o = (o - mu) * lax.rsqrt(var + GN_EPS)
    o = o.transpose(0, 2, 3, 1, 4).reshape(b, s, h * d) * gn_gain.astype(jnp.float32)
    return o.astype(q.dtype)


def clamped_swiglu(hid):
    gate, up = hid[..., :D_FF], hid[..., D_FF:]
    gate = jnp.minimum(gate, SWIGLU_LIMIT)
    up = jnp.clip(up, -SWIGLU_LIMIT, SWIGLU_LIMIT)
    return (up + 1.0) * (gate * jax.nn.sigmoid(SWIGLU_ALPHA * gate))


def moe_ffn(x, w_router, b_router, w_gate_up, b_gate_up, w_down, b_down):
    b, s, dm = x.shape
    t = b * s
    xt = x.reshape(t, dm)
    logits = (xt @ w_router + b_router).astype(jnp.float32)
    top_vals, top_idx = lax.top_k(logits, TOP_K)
    gates = jax.nn.softmax(top_vals, axis=-1)
    tk = t * TOP_K
    flat_e = top_idx.reshape(tk).astype(jnp.int32)
    flat_tok = jnp.arange(tk, dtype=jnp.int32) // TOP_K
    order = jnp.argsort(flat_e)
    sorted_e = flat_e[order]
    sorted_tok = flat_tok[order]
    counts = jnp.bincount(flat_e, length=N_EXPERTS).astype(jnp.int32)
    padded = (counts + MOE_BLOCK - 1) // MOE_BLOCK * MOE_BLOCK
    un_start = jnp.cumsum(counts) - counts
    pad_end = jnp.cumsum(padded)
    pad_start = pad_end - padded
    dest = pad_start[sorted_e] + jnp.arange(tk, dtype=jnp.int32) - un_start[sorted_e]
    n_rows = (tk + MOE_BLOCK - 1) // MOE_BLOCK * MOE_BLOCK + N_EXPERTS * MOE_BLOCK
    n_blocks = n_rows // MOE_BLOCK
    row_tok = jnp.full((n_rows,), t, jnp.int32).at[dest].set(sorted_tok)
    x_pad = jnp.concatenate([xt, jnp.zeros((1, dm), xt.dtype)], axis=0)
    x_rows = x_pad[row_tok].reshape(n_blocks, MOE_BLOCK, dm)
    block_e = jnp.minimum(
        jnp.searchsorted(pad_end, jnp.arange(n_blocks, dtype=jnp.int32) * MOE_BLOCK, side='right'),
        N_EXPERTS - 1)

    def expert_block(args):
        xb, e = args
        hid = xb @ w_gate_up[e] + b_gate_up[e]
        return clamped_swiglu(hid) @ w_down[e] + b_down[e]

    y_rows = lax.map(expert_block, (x_rows, block_e)).reshape(n_rows, dm)
    dest_tok = jnp.zeros((tk,), jnp.int32).at[order].set(dest).reshape(t, TOP_K)
    y = jnp.einsum('tk,tkd->td', gates.astype(y_rows.dtype), y_rows[dest_tok])
    return y.reshape(b, s, dm)


def setup_inputs(seed: int = 0) -> dict:
    key = jax.random.key(seed)
    ks = jax.random.split(key, 16)
    f32 = jnp.float32
    nrm = lambda k, shape: jax.random.normal(k, shape, f32)
    return {
        "x": nrm(ks[0], (BATCH, SEQ, D_MODEL)),
        "w_in": nrm(ks[1], (DEPTH, D_MODEL, IN_WIDTH)) * D_MODEL ** -0.5,
        "ret_gn_gain": 1.0 + 0.02 * nrm(ks[2], (DEPTH, RET_WIDTH)),
        "w_out": nrm(ks[3], (DEPTH, MIX_WIDTH, D_MODEL)) * (MIX_WIDTH ** -0.5 * DEEPNORM_BETA),
        "ln1_gain": 1.0 + 0.02 * nrm(ks[4], (DEPTH, D_MODEL)),
        "ln1_bias": 0.02 * nrm(ks[5], (DEPTH, D_MODEL)),
        "w_router": nrm(ks[6], (DEPTH, D_MODEL, N_EXPERTS)) * D_MODEL ** -0.5,
        "b_router": 0.01 * nrm(ks[7], (DEPTH, N_EXPERTS)),
        "w_gate_up": nrm(ks[8], (DEPTH, N_EXPERTS, D_MODEL, 2 * D_FF)) * D_MODEL ** -0.5,
        "b_gate_up": 0.01 * nrm(ks[9], (DEPTH, N_EXPERTS, 2 * D_FF)),
        "w_down": nrm(ks[10], (DEPTH, N_EXPERTS, D_FF, D_MODEL)) * (D_FF ** -0.5 * DEEPNORM_BETA),
        "b_down": 0.01 * nrm(ks[11], (DEPTH, N_EXPERTS, D_MODEL)),
        "ln2_gain": 1.0 + 0.02 * nrm(ks[12], (DEPTH, D_MODEL)),
        "ln2_bias": 0.02 * nrm(ks[13], (DEPTH, D_MODEL)),
    }


def reference(x, w_in, ret_gn_gain, w_out, ln1_gain, ln1_bias, w_router, b_router,
              w_gate_up, b_gate_up, w_down, b_down, ln2_gain, ln2_bias):
    b, s, _ = x.shape
    splits = [SB_WIDTH, 2 * SB_WIDTH, 3 * SB_WIDTH,
              3 * SB_WIDTH + RET_WIDTH, 3 * SB_WIDTH + 2 * RET_WIDTH, 3 * SB_WIDTH + 3 * RET_WIDTH]
    for layer in range(DEPTH):
        proj = x @ w_in[layer]
        sb_q, sb_k, sb_v, r_q, r_k, r_v, r_g = jnp.split(proj, splits, axis=-1)
        sb_heads = lambda a: a.reshape(b, s, SB_HEADS, HEAD_DIM).transpose(0, 2, 1, 3)
        sb_out = stick_breaking_attention(sb_heads(sb_q), sb_heads(sb_k), sb_heads(sb_v))
        ret_heads = lambda a: a.reshape(b, s, RET_HEADS, HEAD_DIM)
        ret_out = chunk_retention(rotary(ret_heads(r_q)), rotary(ret_heads(r_k)), ret_heads(r_v),
                                  ret_gn_gain[layer]) * jax.nn.silu(r_g)
        mix = jnp.concatenate([sb_out.astype(x.dtype), ret_out.astype(x.dtype)], axis=-1) @ w_out[layer]
        x = layer_norm(DEEPNORM_ALPHA * x + mix, ln1_gain[layer], ln1_bias[layer])
        ffn = moe_ffn(x, w_router[layer], b_router[layer], w_gate_up[layer], b_gate_up[layer],
                      w_down[layer], b_down[layer])
        x = layer_norm(DEEPNORM_ALPHA * x + ffn.astype(x.dtype), ln2_gain[layer], ln2_bias[layer])
    return x
```

```cpp
#include <hip/hip_runtime.h>
#include <cstdio>
#include <cstdint>

#ifndef MK_N_LAUNCHES
#define MK_N_LAUNCHES 1
#endif

namespace {
constexpr int NB = 4, SEQ = 2048, T = NB * SEQ, D = 2048, INW = 7168, NE = 32, TOPK = 4, FF = 2048, HD = 128, NH = 8;
constexpr int C_SBQ = 0, C_SBK = 1024, C_SBV = 2048, C_RQ = 3072, C_RK = 4096, C_RV = 5120, C_RG = 6144;
constexpr float LN_EPS = 1e-5f, GN_EPS = 1e-5f, ALPHA = 1.189207115002721f;
constexpr float QSCALE = 0.08838834764831845f;
constexpr int NPHASE = 8;
constexpr int NTHREADS = 512, NWAVES = 8;

constexpr size_t MiB = 1u << 20;
constexpr size_t WS_CTL = 0, CTL_ZERO_BYTES = 1 * MiB;
constexpr size_t WS_ROPE = 1 * MiB;
constexpr size_t WS_XB = 2 * MiB;
constexpr size_t WS_PROJ = 34 * MiB;
constexpr size_t WS_MIXIN = 146 * MiB;
constexpr size_t WS_X1 = 178 * MiB;
constexpr size_t WS_X1B = 242 * MiB;
constexpr size_t WS_LOGITS = 274 * MiB;
constexpr size_t WS_TOKE = 275 * MiB;
constexpr size_t WS_TOKP = WS_TOKE + 128 * 1024;
constexpr size_t WS_TOKG = WS_TOKP + 128 * 1024;
constexpr size_t WS_SORTED = 276 * MiB;
constexpr size_t WS_H = 278 * MiB;
constexpr size_t WS_Y = 408 * MiB;
constexpr size_t WS_WIN_T = 544 * MiB;
constexpr size_t WS_WOUT_T = 572 * MiB;
constexpr size_t WS_WGU_T = 580 * MiB;
constexpr size_t WS_WD_T = 1092 * MiB;
constexpr size_t WS_X1H = 1348 * MiB;
constexpr size_t WS_RETL = 1380 * MiB;
constexpr size_t WS_END = 1396 * MiB;
constexpr int CW_CNT = 64;
constexpr int CW_RETF = 1024;
constexpr int CW_BAR = 4096;

typedef unsigned short bf16;
typedef float f32x4 __attribute__((ext_vector_type(4)));
#define LAS __attribute__((address_space(3)))

__device__ __forceinline__ float bf2f(unsigned v) { return __uint_as_float(v << 16); }
__device__ __forceinline__ unsigned f2bf(float f) { unsigned u = __float_as_uint(f); return (u + 0x7fffu + ((u >> 16) & 1u)) >> 16; }
__device__ __forceinline__ unsigned pk2(float lo, float hi) { return f2bf(lo) | (f2bf(hi) << 16); }
__device__ __forceinline__ int lane_now() { int l; asm volatile("v_mbcnt_lo_u32_b32 %0, -1, 0\n\tv_mbcnt_hi_u32_b32 %0, -1, %0" : "=v"(l)); return l; }
__device__ __forceinline__ float wave_sum(float v) {
#pragma unroll
    for (int o = 1; o < 64; o <<= 1) v += __shfl_xor(v, o);
    return v;
}

#define XB_TMO      128
#define XB_XCNT(j)  (256  + 64 * (j))
#define XB_XSUB(j)  (1280 + 64 * (j))
#define XB_XGEN(j)  (2304 + 64 * (j))
#define XB_TOP      3328
#define XB_TOPGEN   3392
#define XCD_BAR_WORDS 3456
#define XB_SPIN_CAP (1u << 18)
__device__ __forceinline__ unsigned xb_ld(unsigned* p)              { return __hip_atomic_load(p, __ATOMIC_RELAXED, __HIP_MEMORY_SCOPE_AGENT); }
__device__ __forceinline__ unsigned xb_add(unsigned* p, unsigned v) { return __hip_atomic_fetch_add(p, v, __ATOMIC_RELAXED, __HIP_MEMORY_SCOPE_AGENT); }
__device__ __forceinline__ unsigned xb_xcc_id() { return (unsigned)__builtin_amdgcn_s_getreg((3 << 11) | 20) & 0xFu; }
#define XB_SPIN(cond, bar) do { unsigned _sp = 0; while (cond) { __builtin_amdgcn_s_sleep(1); \
    if ((++_sp & 255u) == 0u) { if (xb_ld(&(bar)[XB_TMO])) break; if (_sp > XB_SPIN_CAP) { atomicAdd(&(bar)[XB_TMO], 1u); break; } } } } while (0)
struct XcdBarrier { unsigned* bar; unsigned x; volatile LAS unsigned* st; };
__device__ __forceinline__ XcdBarrier xcd_barrier_post(unsigned* bar, volatile LAS unsigned* st) {
    XcdBarrier b; b.bar = bar; b.x = xb_xcc_id(); b.st = st;
    if (threadIdx.x == 0) (void)xb_add(&bar[XB_XCNT(b.x)], 1u);
    return b;
}
__device__ __forceinline__ void xcd_barrier_complete(unsigned* bar, unsigned x, unsigned& nloc, unsigned& nx) {
    const unsigned G = gridDim.x * gridDim.y * gridDim.z;
    unsigned sum, cnt, mine, sp = 0u;
    for (;;) {
        sum = 0u; cnt = 0u; mine = 0u;
#pragma unroll
        for (unsigned j = 0; j < 16; ++j) { const unsigned c = xb_ld(&bar[XB_XCNT(j)]); sum += c; cnt += (c > 0u) ? 1u : 0u; mine = (j == x) ? c : mine; }
        if (sum == G) break;
        __builtin_amdgcn_s_sleep(1);
        if ((++sp & 255u) == 0u) { if (xb_ld(&bar[XB_TMO])) break; if (sp > XB_SPIN_CAP) { atomicAdd(&bar[XB_TMO], 1u); break; } }
    }
    nloc = mine > 0u ? mine : 1u; nx = cnt > 0u ? cnt : 1u;
}
__device__ __forceinline__ void xcd_barrier(const XcdBarrier& b, bool leader) {
    asm volatile("s_waitcnt vmcnt(0)" ::: "memory");
    __syncthreads();
    if (leader) {
        unsigned* bar = b.bar;
        __builtin_amdgcn_s_waitcnt(0);
        unsigned nloc = b.st[0], nx = b.st[1];
        if (nloc == 0u) { xcd_barrier_complete(bar, b.x, nloc, nx); b.st[0] = nloc; b.st[1] = nx; }
        const unsigned old = xb_add(&bar[XB_XSUB(b.x)], 1u);
        const unsigned gen = old / nloc;
        if (old + 1u == (gen + 1u) * nloc) {
            __builtin_amdgcn_fence(__ATOMIC_RELEASE, "agent");
            asm volatile("s_waitcnt vmcnt(0)" ::: "memory");
            const unsigned og = xb_add(&bar[XB_TOP], 1u);
            const unsigned tg = og / nx;
            if (og + 1u == (tg + 1u) * nx) xb_add(&bar[XB_TOPGEN], 1u);
            else XB_SPIN(xb_ld(&bar[XB_TOPGEN]) == tg, bar);
            __builtin_amdgcn_fence(__ATOMIC_ACQUIRE, "agent");
            xb_add(&bar[XB_XGEN(b.x)], 1u);
            asm volatile("s_waitcnt vmcnt(0)" ::: "memory");
        } else {
            XB_SPIN(xb_ld(&bar[XB_XGEN(b.x)]) == gen, bar);
            __builtin_amdgcn_fence(__ATOMIC_ACQUIRE, "agent");
            asm volatile("s_waitcnt vmcnt(0)" ::: "memory");
        }
    }
    __syncthreads();
}

struct Args {
    const float* in[14];
    float* out;
    unsigned char* ws;
    int ph_lo, ph_hi;
};
struct Frame {
    LAS unsigned char* lds;
    int tid, lane, wave, G, bid;
    const float *x, *w_in, *gn_gain, *w_out, *ln1_g, *ln1_b, *w_router, *b_router, *w_gu, *b_gu, *w_down, *b_down, *ln2_g, *ln2_b;
    float* out;
    unsigned* ctl;
    float *ropec, *ropes;
    bf16 *xb, *proj, *mixin, *ybuf, *winT, *woutT;
    unsigned char *x1q, *hq, *wguQ, *wdQ;
    bf16* x1h;
    float *x1, *logits, *tokg, *retL;
    int *toke, *tokp, *sorted;
};


namespace pg8 {
typedef short bf16x8 __attribute__((ext_vector_type(8)));
typedef unsigned u32x4 __attribute__((ext_vector_type(4)));
typedef unsigned u32x2 __attribute__((ext_vector_type(2)));
constexpr int BM = 256, BK = 64, HALF = 128, HTB = HALF * BK * 2, STAGE_BYTES = 8 * HTB, NXCD = 8, WGM = 8;
constexpr int KD = 2048;
__device__ __forceinline__ int lds_byte(int r, int c) { const int st = (r >> 4) * 2 + (c >> 5), rr = r & 15, cc = c & 31, ob = rr * 64 + cc * 2; return st * 1024 + (ob ^ (((ob >> 9) & 1) << 5)); }
__device__ __forceinline__ void stage_rc(int b, int& R, int& C) { const int st = b / 1024, sb = b % 1024, swz = sb ^ (((sb >> 9) & 1) << 5); R = (st >> 1) * 16 + swz / 64; C = (st & 1) * 32 + (swz % 64) / 2; }
__device__ __forceinline__ unsigned cvt_pk_bf16(float lo, float hi) { unsigned r; asm volatile("v_cvt_pk_bf16_f32 %0, %1, %2" : "=v"(r) : "v"(lo), "v"(hi)); return r; }

struct Unit { const char *a0, *a1, *b0, *b1; int e0, e1, e2, e3; };

typedef int i32x8 __attribute__((ext_vector_type(8)));
typedef int i32x4 __attribute__((ext_vector_type(4)));
__device__ __forceinline__ i32x8 cat8(bf16x8 lo, bf16x8 hi) { return __builtin_shufflevector(__builtin_bit_cast(i32x4, lo), __builtin_bit_cast(i32x4, hi), 0, 1, 2, 3, 4, 5, 6, 7); }
template <class Epi, class Sched, bool GATHER, int KDV = KD, bool F8 = false>
__device__ __forceinline__ void gemm_phase(LAS unsigned char* lds, const Sched& S, const Epi& E, int wid) {
    const int lane = lane_now(), tid = wid * 64 + lane, wr = wid >> 2, wc = wid & 3, fr = lane & 15, fq = lane >> 4;
    constexpr int K = KDV, nt = K / BK;
    unsigned voffA[2][2], voffB[2]; int sR0, sC0;
    stage_rc(tid * 16, sR0, sC0);
#pragma unroll
    for (int i = 0; i < 2; ++i) { voffB[i] = (unsigned)((sR0 + 64 * i) * K + sC0) * 2u; voffA[0][i] = voffB[i]; voffA[1][i] = voffB[i]; }
    constexpr size_t kstep = (size_t)(BK * 2);
    const unsigned ldsw = (unsigned)wid * 1024u;
    const int aoff = lds_byte(wr * 64 + fr, fq * 8), boff = lds_byte(wc * 32 + fr, fq * 8);
#define PG8_SA(b, h) (((b) * 2 + (h)) * HTB)
#define PG8_SB(b, h) ((4 + (b) * 2 + (h)) * HTB)
#define PG8_STAGE(bufoff, gbase, voff) do { _Pragma("unroll") for (int _i = 0; _i < 2; ++_i) \
        __builtin_amdgcn_global_load_lds((const unsigned*)((const char*)(gbase) + (voff)[_i]), (LAS unsigned*)(lds + (bufoff) + ldsw + _i * 8192), 16, 0, 0); } while (0)
#define PG8_LDA(dst, b, h) do { _Pragma("unroll") for (int m = 0; m < 4; ++m) { if constexpr (F8) { dst##8[m].lo = *(const LAS i32x4*)(lds + PG8_SA(b, h) + aoff + m * 2048); dst##8[m].hi = *(const LAS i32x4*)(lds + PG8_SA(b, h) + aoff + m * 2048 + 1024); } \
        else { _Pragma("unroll") for (int k = 0; k < 2; ++k) dst[m][k] = *(const LAS bf16x8*)(lds + PG8_SA(b, h) + aoff + m * 2048 + k * 1024); } } } while (0)
#define PG8_LDB(dst, b, h) do { _Pragma("unroll") for (int n = 0; n < 2; ++n) { if constexpr (F8) { dst##8[n].lo = *(const LAS i32x4*)(lds + PG8_SB(b, h) + boff + n * 2048); dst##8[n].hi = *(const LAS i32x4*)(lds + PG8_SB(b, h) + boff + n * 2048 + 1024); } \
        else { _Pragma("unroll") for (int k = 0; k < 2; ++k) dst[n][k] = *(const LAS bf16x8*)(lds + PG8_SB(b, h) + boff + n * 2048 + k * 1024); } } } while (0)
#define PG8_MMA(ai, bj, At, Bt) do { __builtin_amdgcn_s_setprio(1); _Pragma("unroll") for (int m = 0; m < 4; ++m) _Pragma("unroll") for (int n = 0; n < 2; ++n) { \
        if constexpr (F8) acc[ai][bj][m][n] = __builtin_amdgcn_mfma_scale_f32_16x16x128_f8f6f4(Bt##8[n], At##8[m], acc[ai][bj][m][n], 0, 0, 0, 0x7f7f7f7f, 0, 0x7f7f7f7f); \
        else { _Pragma("unroll") for (int k = 0; k < 2; ++k) acc[ai][bj][m][n] = __builtin_amdgcn_mfma_f32_16x16x32_bf16(Bt[n][k], At[m][k], acc[ai][bj][m][n], 0, 0, 0); } } __builtin_amdgcn_s_setprio(0); } while (0)
#define PG8_WAIT_V(n) asm volatile("s_waitcnt vmcnt(" #n ")" ::: "memory")
#define PG8_WAIT_L(n) asm volatile("s_waitcnt lgkmcnt(" #n ")" ::: "memory")
#define PG8_BAR __builtin_amdgcn_s_barrier()
#define PG8_SCHED __builtin_amdgcn_sched_barrier(0)
    Unit cur, nxt; int ui = 0;
    if (!S.next(0, cur)) return;
    if constexpr (GATHER) S.voff(cur, sR0, sC0, voffA);
    f32x4 acc[2][2][4][2];
#pragma unroll
    for (int a = 0; a < 2; ++a)
#pragma unroll
        for (int b = 0; b < 2; ++b)
#pragma unroll
            for (int m = 0; m < 4; ++m)
#pragma unroll
                for (int n = 0; n < 2; ++n) acc[a][b][m][n] = (f32x4){0.f, 0.f, 0.f, 0.f};
    bf16x8 At[F8 ? 1 : 4][2], B0[F8 ? 1 : 2][2], B1[F8 ? 1 : 2][2];
    i32x8 At8[F8 ? 4 : 1], B08[F8 ? 2 : 1], B18[F8 ? 2 : 1];
    PG8_STAGE(PG8_SB(0, 0), cur.b0, voffB); PG8_STAGE(PG8_SB(0, 1), cur.b1, voffB); PG8_STAGE(PG8_SA(0, 0), cur.a0, voffA[0]); PG8_STAGE(PG8_SA(0, 1), cur.a1, voffA[1]);
    if (wr == 1) PG8_BAR;
    PG8_WAIT_V(2); PG8_BAR;
    PG8_STAGE(PG8_SB(1, 0), cur.b0 + kstep, voffB); PG8_STAGE(PG8_SA(1, 0), cur.a0 + kstep, voffA[0]); PG8_STAGE(PG8_SB(1, 1), cur.b1 + kstep, voffB);
    PG8_WAIT_V(6); PG8_BAR;
    for (;;) {
        const bool has_next = S.next(ui + 1, nxt);
        if (!has_next) nxt = cur;
        for (int t = 0; t < nt; t += 2) {
            const bool last = (t == nt - 2);
            asm volatile("" : "+v"(voffA[0][0]), "+v"(voffA[0][1]), "+v"(voffA[1][0]), "+v"(voffA[1][1]), "+v"(voffB[0]), "+v"(voffB[1]));
            const char* a1h1 = cur.a1 + (size_t)(t + 1) * kstep;
            const char* a2h0 = last ? nxt.a0 : cur.a0 + (size_t)(t + 2) * kstep; const char* a2h1 = last ? nxt.a1 : cur.a1 + (size_t)(t + 2) * kstep;
            const char* b2h0 = last ? nxt.b0 : cur.b0 + (size_t)(t + 2) * kstep; const char* b2h1 = last ? nxt.b1 : cur.b1 + (size_t)(t + 2) * kstep;
            const char* a3h0 = a2h0 + kstep; const char* b3h0 = b2h0 + kstep; const char* b3h1 = b2h1 + kstep;
            PG8_LDB(B0, 0, 0); PG8_LDB(B1, 0, 1); PG8_SCHED; PG8_LDA(At, 0, 0); PG8_STAGE(PG8_SA(1, 1), a1h1, voffA[1]);
            PG8_WAIT_V(8); PG8_WAIT_L(0); PG8_BAR;
            if constexpr (GATHER) { if (last) S.voff(nxt, sR0, sC0, voffA); }
            PG8_MMA(0, 0, At, B0); PG8_MMA(0, 1, At, B1); PG8_BAR; PG8_SCHED;
            PG8_LDA(At, 0, 1); PG8_STAGE(PG8_SB(0, 0), b2h0, voffB); PG8_STAGE(PG8_SB(0, 1), b2h1, voffB); PG8_STAGE(PG8_SA(0, 0), a2h0, voffA[0]);
            PG8_WAIT_V(8); PG8_WAIT_L(0); PG8_BAR; PG8_MMA(1, 0, At, B0); PG8_MMA(1, 1, At, B1); PG8_BAR; PG8_SCHED;
            PG8_LDB(B0, 1, 0); PG8_LDB(B1, 1, 1); PG8_SCHED; PG8_LDA(At, 1, 0); PG8_STAGE(PG8_SA(0, 1), a2h1, voffA[1]);
            PG8_WAIT_V(8); PG8_WAIT_L(0); PG8_BAR; PG8_MMA(0, 0, At, B0); PG8_MMA(0, 1, At, B1); PG8_BAR; PG8_SCHED;
            PG8_LDA(At, 1, 1); PG8_STAGE(PG8_SB(1, 0), b3h0, voffB); PG8_STAGE(PG8_SB(1, 1), b3h1, voffB); PG8_STAGE(PG8_SA(1, 0), a3h0, voffA[0]);
            PG8_WAIT_V(8); PG8_WAIT_L(0); PG8_BAR; PG8_MMA(1, 0, At, B0); PG8_MMA(1, 1, At, B1); PG8_BAR; PG8_SCHED;
        }
        if (wr == 0) PG8_BAR;
        { const int l2 = lane_now();
          E(acc, cur, wr, wc, l2 & 15, l2 >> 4); }
        if (!has_next) break;
#pragma unroll
        for (int a = 0; a < 2; ++a)
#pragma unroll
            for (int b = 0; b < 2; ++b)
#pragma unroll
                for (int m = 0; m < 4; ++m)
#pragma unroll
                    for (int n = 0; n < 2; ++n) acc[a][b][m][n] = (f32x4){0.f, 0.f, 0.f, 0.f};
        cur = nxt; ++ui;
        if (wr == 1) PG8_BAR;
    }
    PG8_WAIT_V(0);
    PG8_BAR;
#undef PG8_SA
#undef PG8_SB
#undef PG8_STAGE
#undef PG8_LDA
#undef PG8_LDB
#undef PG8_MMA
#undef PG8_WAIT_V
#undef PG8_WAIT_L
#undef PG8_BAR
#undef PG8_SCHED
}
}

constexpr int EXPTAB_OFF = 133120;
struct ExpTab { LAS int* cnt; LAS int* off; LAS int* tpre; };
struct DenseSched {
    const char* A; const char* Bt; int nM, nN, nwg, G, c, gm;
    __device__ __forceinline__ void init(const void* A_, const void* Bt_, int M, int N, int G_, int c_, int gm_ = 8) { A = (const char*)A_; Bt = (const char*)Bt_; nM = M / 256; nN = N / 256; nwg = nM * nN; G = G_; c = c_; gm = gm_; }
    __device__ __forceinline__ bool next(int i, pg8::Unit& u) const {
        const long L = (long)i * G + c; if (L >= nwg) return false;
        int wgid = (int)L; { const int q = nwg / 8, r = nwg % 8, xcd = wgid % 8, off = wgid / 8; wgid = (xcd < r ? xcd * (q + 1) : r * (q + 1) + (xcd - r) * q) + off; }
        const int nig = gm * nN, gid = wgid / nig, fm = gid * gm, gsz = (nM - fm) < gm ? (nM - fm) : gm;
        const int pm = fm + ((wgid % nig) % gsz), pn = (wgid % nig) / gsz;
        constexpr size_t hstep = (size_t)128 * pg8::KD * 2;
        u.a0 = A + (size_t)pm * 2 * hstep; u.a1 = u.a0 + hstep; u.b0 = Bt + (size_t)pn * 2 * hstep; u.b1 = u.b0 + hstep; u.e0 = pm; u.e1 = pn; u.e2 = 0; u.e3 = 0; return true;
    }
    __device__ __forceinline__ void voff(const pg8::Unit&, int, int, unsigned (&)[2][2]) const {}
};
struct MoeSched {
    ExpTab X; const char* A; const char* Bt; const int* sorted; int NT, G, v; bool up;
    static constexpr int KQ = 1024;
    __device__ __forceinline__ bool next(int i, pg8::Unit& u) const {
#define RFL(x) __builtin_amdgcn_readfirstlane(x)
        const int L = i * G + v; if (L >= RFL(X.tpre[NE]) * NT) return false;
        const int ln = lane_now();
        const int e = __builtin_popcountll(__ballot(ln < NE && X.tpre[(ln & 31) + 1] * NT <= L));
        const int tp0 = RFL(X.tpre[e]), ntl = RFL(X.tpre[e + 1]) - tp0, r = L - tp0 * NT, nt = r / ntl, mt = r - nt * ntl;
        constexpr size_t hstep = (size_t)128 * KQ * 2;
        u.e0 = e; u.e1 = mt; u.e2 = nt; u.e3 = RFL(X.cnt[e]);
        u.b0 = Bt + (size_t)(e * NT + nt) * 2 * hstep; u.b1 = u.b0 + hstep;
        if (up) { u.a0 = A; u.a1 = A; }
        else { u.a0 = A + (size_t)(RFL(X.off[e]) + mt * 256) * KQ * 2; u.a1 = u.a0 + hstep; }
#undef RFL
        return true;
    }
    __device__ __forceinline__ void voff(const pg8::Unit& u, int R0, int C0, unsigned (&v)[2][2]) const {
        if (up) { const int* srt = sorted + (size_t)u.e0 * T;
#pragma unroll
            for (int h = 0; h < 2; ++h)
#pragma unroll
                for (int i = 0; i < 2; ++i) { int p = u.e1 * 256 + h * 128 + 64 * i + R0; p = p < u.e3 ? p : 0; v[h][i] = (unsigned)(srt[p] * KQ + C0) * 2u; } }
        else {
#pragma unroll
            for (int h = 0; h < 2; ++h)
#pragma unroll
                for (int i = 0; i < 2; ++i) v[h][i] = (unsigned)((64 * i + R0) * KQ + C0) * 2u; }
    }
};

struct EpiProj {
    bf16* proj; const float* rc; const float* rs;
    __device__ __forceinline__ void operator()(const f32x4 (&acc)[2][2][4][2], const pg8::Unit& u, int wr, int wc, int fr, int fq) const {
        const int row0 = u.e0 * 256 + wr * 64 + fr, i0 = 16 * wc + 4 * fq;
#pragma unroll
        for (int bj = 0; bj < 2; ++bj) {
            const int hb = u.e1 * 256 + bj * 128;
            const bool rot = (hb >= C_RQ && hb < C_RV);
            const float sc = (hb < C_SBK || (hb >= C_RK && hb < C_RV)) ? QSCALE : 1.0f;
#pragma unroll
            for (int ai = 0; ai < 2; ++ai)
#pragma unroll
                for (int m = 0; m < 4; ++m) {
                    const int row = row0 + ai * 128 + m * 16;
                    f32x4 v0 = acc[ai][bj][m][0], v1 = acc[ai][bj][m][1];
                    if (rot) { const int pos = row & (SEQ - 1); const f32x4 c = *(const f32x4*)(rc + pos * 64 + i0), s = *(const f32x4*)(rs + pos * 64 + i0);
                        const f32x4 o0 = v0 * c - v1 * s, o1 = v0 * s + v1 * c; v0 = o0; v1 = o1; }
                    v0 = v0 * sc; v1 = v1 * sc;
                    pg8::u32x2 w; w.x = pg8::cvt_pk_bf16(v0[0], v0[1]); w.y = pg8::cvt_pk_bf16(v0[2], v0[3]);
                    *(pg8::u32x2*)(proj + (size_t)row * INW + hb + i0) = w;
                    w.x = pg8::cvt_pk_bf16(v1[0], v1[1]); w.y = pg8::cvt_pk_bf16(v1[2], v1[3]);
                    *(pg8::u32x2*)(proj + (size_t)row * INW + hb + 64 + i0) = w;
                }
        }
    }
};
struct EpiOut {
    const float* x; float* x1;
    __device__ __forceinline__ void operator()(const f32x4 (&acc)[2][2][4][2], const pg8::Unit& u, int wr, int wc, int fr, int fq) const {
        const int row0 = u.e0 * 256 + wr * 64 + fr, col0 = u.e1 * 256 + wc * 32 + 4 * fq;
#pragma unroll
        for (int ai = 0; ai < 2; ++ai)
#pragma unroll
            for (int m = 0; m < 4; ++m) { const size_t o = (size_t)(row0 + ai * 128 + m * 16) * D + col0;
#pragma unroll
                for (int bj = 0; bj < 2; ++bj)
#pragma unroll
                    for (int n = 0; n < 2; ++n) { const f32x4 xv = *(const f32x4*)(x + o + bj * 128 + n * 16); *(f32x4*)(x1 + o + bj * 128 + n * 16) = xv * ALPHA + acc[ai][bj][m][n]; } }
    }
};
constexpr float WQ_SCALE = 64.0f, WQ_INV = 1.0f / 64.0f;
struct EpiUp {
    unsigned char* hb; const float* bgu; ExpTab X;
    __device__ __forceinline__ void operator()(const f32x4 (&acc)[2][2][4][2], const pg8::Unit& u, int wr, int wc, int fr, int fq) const {
        const int e = u.e0, cnt = u.e3, off = X.off[e], f0 = u.e2 * 128 + 32 * wc + 8 * fq;
        const float* bg = bgu + (size_t)e * 2 * FF;
        f32x4 bgv[2], buv[2];
#pragma unroll
        for (int n = 0; n < 2; ++n) { bgv[n] = *(const f32x4*)(bg + f0 + 4 * n); buv[n] = *(const f32x4*)(bg + FF + f0 + 4 * n); }
#pragma unroll
        for (int ai = 0; ai < 2; ++ai)
#pragma unroll
            for (int m = 0; m < 4; ++m) {
                const int p = u.e1 * 256 + ai * 128 + wr * 64 + m * 16 + fr;
                float hv[8];
#pragma unroll
                for (int n = 0; n < 2; ++n) { const f32x4 g = acc[ai][0][m][n] * WQ_INV + bgv[n], uu = acc[ai][1][m][n] * WQ_INV + buv[n];
#pragma unroll
                    for (int j = 0; j < 4; ++j) { const float gate = fminf(g[j], 7.0f), up = fminf(fmaxf(uu[j], -7.0f), 7.0f);
                        hv[4 * n + j] = (up + 1.0f) * gate * __builtin_amdgcn_rcpf(1.0f + __builtin_amdgcn_exp2f(-1.702f * 1.4426950408889634f * gate)); } }
                if (p < cnt) { pg8::u32x2 w; int t0 = __builtin_amdgcn_cvt_pk_fp8_f32(hv[0], hv[1], 0, false); t0 = __builtin_amdgcn_cvt_pk_fp8_f32(hv[2], hv[3], t0, true);
                    int t1 = __builtin_amdgcn_cvt_pk_fp8_f32(hv[4], hv[5], 0, false); t1 = __builtin_amdgcn_cvt_pk_fp8_f32(hv[6], hv[7], t1, true); w.x = (unsigned)t0; w.y = (unsigned)t1;
                    *(pg8::u32x2*)(hb + (size_t)(off + p) * FF + f0) = w; }
            }
    }
};
struct EpiDown {
    bf16* yb; const float* bdn; ExpTab X;
    __device__ __forceinline__ void operator()(const f32x4 (&acc)[2][2][4][2], const pg8::Unit& u, int wr, int wc, int fr, int fq) const {
        const int e = u.e0, cnt = u.e3, off = X.off[e], c0 = u.e2 * 256 + 32 * wc + 8 * fq;
        const float* bd = bdn + (size_t)e * D;
#pragma unroll
        for (int bj = 0; bj < 2; ++bj) {
            const f32x4 b0 = *(const f32x4*)(bd + c0 + bj * 128), b1 = *(const f32x4*)(bd + c0 + bj * 128 + 4);
#pragma unroll
            for (int ai = 0; ai < 2; ++ai)
#pragma unroll
                for (int m = 0; m < 4; ++m) {
                    const int p = u.e1 * 256 + ai * 128 + wr * 64 + m * 16 + fr;
                    const f32x4 v0 = acc[ai][bj][m][0] * WQ_INV + b0, v1 = acc[ai][bj][m][1] * WQ_INV + b1;
                    pg8::u32x4 w; w.x = pg8::cvt_pk_bf16(v0[0], v0[1]); w.y = pg8::cvt_pk_bf16(v0[2], v0[3]); w.z = pg8::cvt_pk_bf16(v1[0], v1[1]); w.w = pg8::cvt_pk_bf16(v1[2], v1[3]);
                    if (p < cnt) *(pg8::u32x4*)(yb + (size_t)(off + p) * D + c0 + bj * 128) = w;
                }
        }
    }
};

struct EpiMoe {
    bool up; EpiUp eu; EpiDown ed;
    __device__ __forceinline__ void operator()(const f32x4 (&acc)[2][2][4][2], const pg8::Unit& u, int wr, int wc, int fr, int fq) const { if (up) eu(acc, u, wr, wc, fr, fq); else ed(acc, u, wr, wc, fr, fq); }
};
__device__ __forceinline__ void ph_prologue(Frame& F) {
    const size_t gt = (size_t)F.bid * NTHREADS + F.tid, gs = (size_t)F.G * NTHREADS;
    const float4* x4 = (const float4*)F.x; uint2* o2 = (uint2*)F.xb;
    for (size_t i = gt; i < (size_t)T * D / 4; i += gs) { const float4 v = x4[i]; uint2 o; o.x = pk2(v.x, v.y); o.y = pk2(v.z, v.w); o2[i] = o; }
    for (size_t i = gt; i < (size_t)SEQ * 64; i += gs) {
        const int pos = (int)(i >> 6), f = (int)(i & 63);
        const float invf = exp2f(-(float)f * (13.287712379549449f / 64.0f));
        const float ang = (float)pos * invf;
        double rev = (double)ang * 0.15915494309189535; rev -= floor(rev);
        F.ropec[i] = __builtin_amdgcn_cosf((float)rev); F.ropes[i] = __builtin_amdgcn_sinf((float)rev);
    }
}


__device__ __forceinline__ int rho8(int c) { return 32 * (c >> 5) + 16 * ((c >> 2) & 1) + 4 * ((c >> 3) & 3) + (c & 3); }
constexpr int I_IN = (D / 64) * (INW / 32), I_OUT = (D / 64) * (D / 32), I_GU = (D / 64) * (2 * FF / 32), I_DN = (FF / 64) * (D / 32);
constexpr int I_DENSE = I_IN + I_OUT, I_ALL = I_DENSE + NE * (I_GU + I_DN);
#ifndef W_PROJ
#define W_PROJ 128
#endif
#ifndef W_MIX
#define W_MIX 128
#endif
#ifndef W_OUT
#define W_OUT 256
#endif
#ifndef CONV_F0
#define CONV_F0 0.1
#endif
#ifndef CONV_F1
#define CONV_F1 0.7
#endif
#ifndef CONV_F2
#define CONV_F2 1.0
#endif
constexpr int I_MOE = I_ALL - I_DENSE;
constexpr int I_R0 = I_DENSE + (int)(I_MOE * (double)(CONV_F0)), I_R1 = I_DENSE + (int)(I_MOE * (double)(CONV_F1)), I_R2 = I_DENSE + (int)(I_MOE * (double)(CONV_F2));
struct CItem { const float* wp; void* WT; int N, n0, k0, kind; };
__device__ __forceinline__ CItem conv_decode(const Frame& F, int it, int lane) {
    CItem c; int r = it; const float* W; int kb, nb;
    if (r < I_IN) { W = F.w_in; c.N = INW; c.WT = F.winT; c.kind = 0; }
    else if ((r -= I_IN) < I_OUT) { W = F.w_out; c.N = D; c.WT = F.woutT; c.kind = 1; }
    else { r -= I_OUT; const int e = r / (I_GU + I_DN); r -= e * (I_GU + I_DN);
        if (r < I_GU) { W = F.w_gu + (size_t)e * D * 2 * FF; c.N = 2 * FF; c.WT = F.wguQ + (size_t)e * 2 * FF * D; c.kind = 2; }
        else { r -= I_GU; W = F.w_down + (size_t)e * FF * D; c.N = D; c.WT = F.wdQ + (size_t)e * D * FF; c.kind = 3; } }
    const int nblk = c.N / 32; kb = r / nblk; nb = r - kb * nblk; c.k0 = 64 * kb; c.n0 = 32 * nb;
    c.wp = W + (size_t)(c.k0 + (lane >> 3)) * c.N + c.n0 + 4 * (lane & 7);
    return c;
}
__device__ __forceinline__ void conv_load(const CItem& c, f32x4 (&v)[8]) {
#pragma unroll
    for (int i = 0; i < 8; ++i) v[i] = __builtin_nontemporal_load((const f32x4*)(c.wp + (size_t)(8 * i) * c.N));
}
__device__ __forceinline__ int conv_row(int kind, int n) {
    const int c = n & 127;
    if (kind == 0) return (n & ~127) + 32 * ((c >> 4) & 3) + 16 * (c >> 6) + (c & 15);
    if (kind == 1) return n;
    if (kind == 2) { const int half = n >> 11, f = n & 2047; return (f >> 7) * 256 + half * 128 + rho8(f & 127); }
    return (n & ~127) + rho8(c);
}
__device__ __forceinline__ void conv_store(const CItem& c, const f32x4 (&v)[8], LAS float* scr, int lane) {
    {   LAS float* wq = scr + (lane >> 3) * 33 + 4 * (lane & 7);
#pragma unroll
        for (int i = 0; i < 8; ++i) { wq[(8 * i) * 33 + 0] = v[i][0]; wq[(8 * i) * 33 + 1] = v[i][1]; wq[(8 * i) * 33 + 2] = v[i][2]; wq[(8 * i) * 33 + 3] = v[i][3]; } }
    asm volatile("s_waitcnt lgkmcnt(0)" ::: "memory");
    if (c.kind < 2) {
        const int ch = lane >> 3;
#pragma unroll
        for (int j = 0; j < 4; ++j) { const int n = (lane & 7) + 8 * j; const LAS float* sp = scr + (8 * ch) * 33 + n;
            pg8::u32x4 o; o.x = pg8::cvt_pk_bf16(sp[0 * 33], sp[1 * 33]); o.y = pg8::cvt_pk_bf16(sp[2 * 33], sp[3 * 33]); o.z = pg8::cvt_pk_bf16(sp[4 * 33], sp[5 * 33]); o.w = pg8::cvt_pk_bf16(sp[6 * 33], sp[7 * 33]);
            *(pg8::u32x4*)((bf16*)c.WT + (size_t)conv_row(c.kind, c.n0 + n) * D + c.k0 + 8 * ch) = o; }
    } else {
        const int ch = lane >> 4;
#pragma unroll
        for (int j = 0; j < 2; ++j) { const int n = (lane & 15) + 16 * j; const LAS float* sp = scr + (16 * ch) * 33 + n; pg8::u32x4 o;
#pragma unroll
            for (int d = 0; d < 4; ++d) { int t = __builtin_amdgcn_cvt_pk_fp8_f32(sp[(4 * d) * 33] * WQ_SCALE, sp[(4 * d + 1) * 33] * WQ_SCALE, 0, false);
                t = __builtin_amdgcn_cvt_pk_fp8_f32(sp[(4 * d + 2) * 33] * WQ_SCALE, sp[(4 * d + 3) * 33] * WQ_SCALE, t, true); o[d] = (unsigned)t; }
            __builtin_nontemporal_store(o, (pg8::u32x4*)((unsigned char*)c.WT + (size_t)conv_row(c.kind, c.n0 + n) * D + c.k0 + 16 * ch)); }
    }
    asm volatile("s_waitcnt lgkmcnt(0)" ::: "memory");
}
__device__ __forceinline__ CItem conv_decode_moe(const Frame& F, int it, int lane) {
    CItem c; int r = it - I_DENSE; const int e = r / (I_GU + I_DN); r -= e * (I_GU + I_DN);
    const bool gu = r < I_GU; const int r2 = gu ? r : r - I_GU, sh = gu ? 7 : 6;
    const int kb = r2 >> sh, nb = r2 & ((1 << sh) - 1);
    c.N = gu ? 2 * FF : D; c.kind = gu ? 2 : 3; c.k0 = 64 * kb; c.n0 = 32 * nb;
    const float* W = gu ? F.w_gu + (size_t)e * D * 2 * FF : F.w_down + (size_t)e * FF * D;
    c.WT = gu ? (void*)(F.wguQ + (size_t)e * 2 * FF * D) : (void*)(F.wdQ + (size_t)e * D * FF);
    c.wp = W + (size_t)(c.k0 + (lane >> 3)) * c.N + c.n0 + 4 * (lane & 7);
    return c;
}
__device__ __forceinline__ void conv_store_moe(const CItem& c, const f32x4 (&v)[8], LAS float* scr, int lane) {
    {   LAS float* wq = scr + (lane >> 3) * 33 + 4 * (lane & 7);
#pragma unroll
        for (int i = 0; i < 8; ++i) { wq[(8 * i) * 33 + 0] = v[i][0]; wq[(8 * i) * 33 + 1] = v[i][1]; wq[(8 * i) * 33 + 2] = v[i][2]; wq[(8 * i) * 33 + 3] = v[i][3]; } }
    asm volatile("s_waitcnt lgkmcnt(0)" ::: "memory");
    const int ch = lane >> 4;
#pragma unroll
    for (int j = 0; j < 2; ++j) { const int n = (lane & 15) + 16 * j, nn = c.n0 + n; const LAS float* sp = scr + (16 * ch) * 33 + n; pg8::u32x4 o;
#pragma unroll
        for (int d = 0; d < 4; ++d) { int t = __builtin_amdgcn_cvt_pk_fp8_f32(sp[(4 * d) * 33] * WQ_SCALE, sp[(4 * d + 1) * 33] * WQ_SCALE, 0, false);
            t = __builtin_amdgcn_cvt_pk_fp8_f32(sp[(4 * d + 2) * 33] * WQ_SCALE, sp[(4 * d + 3) * 33] * WQ_SCALE, t, true); o[d] = (unsigned)t; }
        const int f = nn & 2047, row2 = (f >> 7) * 256 + (nn >> 11) * 128 + rho8(f & 127), row3 = (nn & ~127) + rho8(nn & 127);
        __builtin_nontemporal_store(o, (pg8::u32x4*)((unsigned char*)c.WT + (size_t)(c.kind == 2 ? row2 : row3) * D + c.k0 + 16 * ch)); }
    asm volatile("s_waitcnt lgkmcnt(0)" ::: "memory");
}
__device__ __forceinline__ void conv_items(Frame& F, int first, int last, int gw, int NGW) {
    LAS float* scr = (LAS float*)(F.lds + F.wave * 16384);
    const int lane = lane_now();
    int it = first + gw; if (it >= last) return;
    CItem c0, c1, c2, c3; f32x4 v0[8], v1[8], v2[8], v3[8];
#define CV_LOAD(c, v, idx) do { if ((idx) < last) { c = conv_decode(F, (idx), lane); conv_load(c, v); } } while (0)
#define CV_STORE(c, v, idx) do { if ((idx) < last) conv_store(c, v, scr, lane); } while (0)
#define CV_LOADU(c, v, idx) do { c = conv_decode_moe(F, (idx), lane); conv_load(c, v); } while (0)
    if (first >= I_DENSE && it + 6 * NGW < last) {
        CV_LOADU(c0, v0, it); CV_LOADU(c1, v1, it + NGW); CV_LOADU(c2, v2, it + 2 * NGW);
        for (; it + 6 * NGW < last; it += 4 * NGW) {
            CV_LOADU(c3, v3, it + 3 * NGW); conv_store_moe(c0, v0, scr, lane);
            CV_LOADU(c0, v0, it + 4 * NGW); conv_store_moe(c1, v1, scr, lane);
            CV_LOADU(c1, v1, it + 5 * NGW); conv_store_moe(c2, v2, scr, lane);
            CV_LOADU(c2, v2, it + 6 * NGW); conv_store_moe(c3, v3, scr, lane);
        }
    } else { CV_LOAD(c0, v0, it); CV_LOAD(c1, v1, it + NGW); CV_LOAD(c2, v2, it + 2 * NGW); }
#undef CV_LOADU
    for (; it < last; it += 4 * NGW) {
        CV_LOAD(c3, v3, it + 3 * NGW); CV_STORE(c0, v0, it);
        CV_LOAD(c0, v0, it + 4 * NGW); CV_STORE(c1, v1, it + NGW);
        CV_LOAD(c1, v1, it + 5 * NGW); CV_STORE(c2, v2, it + 2 * NGW);
        CV_LOAD(c2, v2, it + 6 * NGW); CV_STORE(c3, v3, it + 3 * NGW);
    }
#undef CV_LOAD
#undef CV_STORE
}
__device__ __forceinline__ void conv_role(Frame& F, int first, int last, int w) { conv_items(F, first, last, (F.bid - w) * NWAVES + F.wave, (F.G - w) * NWAVES); }
__device__ __forceinline__ bool role_split(const Frame& F) { return F.G == 256; }
__device__ __forceinline__ void ph_prologue_w(Frame& F) { conv_items(F, 0, role_split(F) ? I_R0 : I_ALL, F.bid * NWAVES + F.wave, F.G * NWAVES); }

__device__ __forceinline__ int vcu_of(const Frame& F) { return (F.G % 8 == 0) ? (F.bid % 8) * (F.G / 8) + F.bid / 8 : F.bid; }
__device__ __forceinline__ void ph_proj(Frame& F) {
    const int gc = role_split(F) ? W_PROJ : F.G;
    if (F.bid < gc) {
        DenseSched S; S.init(F.xb, F.winT, T, INW, gc, F.bid, gc == 128 ? 4 : 8);
        EpiProj E{F.proj, F.ropec, F.ropes};
        pg8::gemm_phase<EpiProj, DenseSched, false>(F.lds, S, E, F.wave);
    } else conv_role(F, I_R0, I_R1, gc);
}
__device__ __forceinline__ void ph_outproj(Frame& F) {
    const int gc = role_split(F) ? W_OUT : F.G;
    if (F.bid < gc) {
        DenseSched S; S.init(F.mixin, F.woutT, T, D, gc, F.bid);
        EpiOut E{F.x, F.x1};
        pg8::gemm_phase<EpiOut, DenseSched, false>(F.lds, S, E, F.wave);
    } else conv_role(F, I_R2, I_ALL, gc);
}
__device__ __forceinline__ ExpTab build_exptab(Frame& F, int TM, int lds_off);
__device__ __forceinline__ void ph_moe(Frame& F, int upflag) {
    asm volatile("" : "+s"(upflag));
    const bool up = upflag != 0;
    ExpTab X = build_exptab(F, 256, EXPTAB_OFF);
    MoeSched S{X, (const char*)(up ? F.x1q : F.hq), (const char*)(up ? F.wguQ : F.wdQ), F.sorted, up ? FF / 128 : D / 256, F.G, vcu_of(F), up};
    EpiMoe E{up, EpiUp{F.hq, F.b_gu, X}, EpiDown{F.ybuf, F.b_down, X}};
    pg8::gemm_phase<EpiMoe, MoeSched, true, MoeSched::KQ, true>(F.lds, S, E, F.wave);
}
__device__ __forceinline__ void ph_moe_up(Frame& F) { ph_moe(F, 1); }
__device__ __forceinline__ void ph_moe_down(Frame& F) { ph_moe(F, 0); }


namespace mx {
typedef short bf16x8 __attribute__((ext_vector_type(8)));
typedef float f32x16 __attribute__((ext_vector_type(16)));
typedef unsigned u32x2 __attribute__((ext_vector_type(2)));
typedef unsigned u32x4 __attribute__((ext_vector_type(4)));
constexpr float LOG2E = 1.4426950408889634f, LN2 = 0.6931471805599453f;
__device__ __forceinline__ unsigned offrw(unsigned row, unsigned byte) { return 272u * row + byte; }
__device__ __forceinline__ unsigned offtr(unsigned row, unsigned byte) { return 320u * row + 32u * ((row >> 3) & 1u) + byte; }
#define MX_TRRD(dst, base, imm) asm volatile("ds_read_b64_tr_b16 %0, %1 offset:%c2" : "=&v"(dst) : "v"(base), "i"(imm) : "memory")
__device__ __forceinline__ bf16x8 frag(u32x2 lo, u32x2 hi) { u32x4 v; v.x = lo.x; v.y = lo.y; v.z = hi.x; v.w = hi.y; return __builtin_bit_cast(bf16x8, v); }
#define MX_DPP(x, ctrl) __builtin_bit_cast(float, __builtin_amdgcn_mov_dpp(__builtin_bit_cast(int, (x)), (ctrl), 0xf, 0xf, true))
__device__ __forceinline__ float row16_sum(float x) { x += MX_DPP(x, 0xB1); x += MX_DPP(x, 0x4E); x += MX_DPP(x, 0x141); x += MX_DPP(x, 0x140); return x; }
__device__ __forceinline__ float softplus_fast(float z) { const float e = __builtin_amdgcn_exp2f(-fabsf(z) * LOG2E); return fmaxf(z, 0.f) + __builtin_amdgcn_logf(1.0f + e) * LN2; }

__device__ __forceinline__ void sb_unit(Frame& F, int unit) {
    const int lane = lane_now(), w = F.wave, tid = w * 64 + lane, hh = lane >> 5, ql = lane & 31;
    const int qb = unit & 7, h = (unit >> 3) & 7, b = unit >> 6;
    const int q0 = qb * 256, qw0 = q0 + 32 * w, tq = qw0 + ql;
    const bf16* base = F.proj + (size_t)(b * SEQ) * INW + h * HD;
    const unsigned lb = (unsigned)(size_t)F.lds;
    constexpr int SB_V = 0, SB_K = 40960, SB_VB = 20480, SB_KB = 17408;
    LAS int* flags = (LAS int*)(F.lds + 75776);
    bf16x8 qf[8];
#pragma unroll
    for (int s = 0; s < 8; ++s) qf[s] = *(const bf16x8*)(base + (size_t)tq * INW + C_SBQ + 16 * s + 8 * hh);
    f32x16 oacc[4];
#pragma unroll
    for (int c = 0; c < 4; ++c)
#pragma unroll
        for (int r = 0; r < 16; ++r) oacc[c][r] = 0.f;
    float carry = 0.f;
    const int kt0 = qb * 4 + 3;
    u32x4 pk[2], pv[2];
    const int srow = tid >> 4, sch = tid & 15;
#define SB_GLOAD(kt) do { _Pragma("unroll") for (int i = 0; i < 2; ++i) { const bf16* p = base + (size_t)(64 * (kt) + srow + 32 * i) * INW + 8 * sch; pk[i] = *(const u32x4*)(p + C_SBK); pv[i] = *(const u32x4*)(p + C_SBV); } } while (0)
#define SB_LSTORE(buf) do { _Pragma("unroll") for (int i = 0; i < 2; ++i) { *(LAS u32x4*)(F.lds + SB_K + (buf) * SB_KB + offrw(srow + 32 * i, 16 * sch)) = pk[i]; *(LAS u32x4*)(F.lds + SB_V + (buf) * SB_VB + offtr(srow + 32 * i, 16 * sch)) = pv[i]; } } while (0)
    __syncthreads();
    SB_GLOAD(kt0); SB_LSTORE(0);
    __syncthreads();
    bool wdone = false;
    const int tq4 = (lane & 15) >> 2, tp = lane & 3, tblk = (lane >> 4) & 1;
    const unsigned kl = 272u * ql + 16u * hh, vl = lb + 320u * (4 * hh + tq4) + 32u * tblk + 8u * tp;
    for (int kt = kt0; kt >= 0; --kt) {
        const int cur = (kt0 - kt) & 1;
        if (kt > 0) SB_GLOAD(kt - 1);
        if (!wdone) {
#pragma unroll 1
            for (int sb = 1; sb >= 0; --sb) {
                const int kmin = 64 * kt + 32 * sb;
                if (kmin >= qw0 + 31) continue;
                f32x16 z;
#pragma unroll
                for (int r = 0; r < 16; ++r) z[r] = 0.f;
#pragma unroll
                for (int s = 0; s < 8; ++s) { const bf16x8 a = *(const LAS bf16x8*)(F.lds + SB_K + cur * SB_KB + 272 * 32 * sb + kl + 32 * s); z = __builtin_amdgcn_mfma_f32_32x32x16_bf16(a, qf[s], z, 0, 0, 0); }
                float l[16], Gs[4], Go[4];
#pragma unroll
                for (int r = 0; r < 16; ++r) { const int key = kmin + 8 * (r >> 2) + 4 * hh + (r & 3); l[r] = (key < tq) ? -softplus_fast(z[r]) : 0.f; }
#pragma unroll
                for (int g = 0; g < 4; ++g) { Gs[g] = (l[4 * g] + l[4 * g + 1]) + (l[4 * g + 2] + l[4 * g + 3]); Go[g] = __shfl_xor(Gs[g], 32); }
                float accs = carry, wv[16];
#pragma unroll
                for (int g = 3; g >= 0; --g) {
                    const float bs = accs + (hh == 0 ? Go[g] : 0.f); float suf = 0.f;
#pragma unroll
                    for (int i = 3; i >= 0; --i) { const int r = 4 * g + i; const int key = kmin + 8 * g + 4 * hh + i;
                        const float lw = (z[r] + l[r]) + (bs + suf);
                        wv[r] = (key < tq) ? __builtin_amdgcn_exp2f(lw * LOG2E) : 0.f; suf += l[r]; }
                    accs += Gs[g] + Go[g];
                }
                carry = accs;
#pragma unroll
                for (int s2 = 0; s2 < 2; ++s2) {
                    u32x4 pw; pw.x = pg8::cvt_pk_bf16(wv[8 * s2 + 0], wv[8 * s2 + 1]); pw.y = pg8::cvt_pk_bf16(wv[8 * s2 + 2], wv[8 * s2 + 3]);
                    pw.z = pg8::cvt_pk_bf16(wv[8 * s2 + 4], wv[8 * s2 + 5]); pw.w = pg8::cvt_pk_bf16(wv[8 * s2 + 6], wv[8 * s2 + 7]);
                    const bf16x8 pb = __builtin_bit_cast(bf16x8, pw);
                    u32x2 t0[4], t1[4];
                    const unsigned vb = vl + SB_V + cur * SB_VB + 320 * 32 * sb;
#pragma unroll
                    for (int c = 0; c < 4; ++c) { MX_TRRD(t0[c], vb, 5120 * s2 + 64 * c); MX_TRRD(t1[c], vb, 5120 * s2 + 2560 + 32 + 64 * c); }
                    asm volatile("s_waitcnt lgkmcnt(0)" : "+v"(t0[0]), "+v"(t0[1]), "+v"(t0[2]), "+v"(t0[3]), "+v"(t1[0]), "+v"(t1[1]), "+v"(t1[2]), "+v"(t1[3]) :: "memory");
#pragma unroll
                    for (int c = 0; c < 4; ++c) oacc[c] = __builtin_amdgcn_mfma_f32_32x32x16_bf16(frag(t0[c], t1[c]), pb, oacc[c], 0, 0, 0);
                }
            }
            wdone = __all(carry < -104.0f) != 0;
        }
        if (kt > 0) SB_LSTORE(cur ^ 1);
        if (lane == 0) flags[(kt & 1) * 8 + w] = wdone ? 1 : 0;
        __syncthreads();
        int all = 1;
#pragma unroll
        for (int i = 0; i < 8; ++i) all &= flags[(kt & 1) * 8 + i];
        if (all) break;
    }
#undef SB_GLOAD
#undef SB_LSTORE
    bf16* orow = F.mixin + (size_t)(b * SEQ + tq) * D + h * HD;
#pragma unroll
    for (int c = 0; c < 4; ++c)
#pragma unroll
        for (int g4 = 0; g4 < 4; ++g4) { u32x2 o; o.x = pg8::cvt_pk_bf16(oacc[c][4 * g4], oacc[c][4 * g4 + 1]); o.y = pg8::cvt_pk_bf16(oacc[c][4 * g4 + 2], oacc[c][4 * g4 + 3]);
            *(u32x2*)(orow + 32 * c + 8 * g4 + 4 * hh) = o; }
}

constexpr int R_KD = 0, R_VT = 20480, R_QT = 40960, R_KT = 58368, R_ST = 75776, R_PT = 110592, R_GNP = 119808, R_GNS = 123904, R_PPITCH = 144;
template <int MODE>
__device__ __forceinline__ void ret_unit(Frame& F, int unit) {
    const int lane = lane_now(), w = F.wave, tid = w * 64 + lane, g = lane >> 4, l15 = lane & 15;
    const int seg = unit & 7, h = (unit >> 3) & 7, b = unit >> 6;
    if (MODE == 0 && seg == 7) return;
    const float l2g = log1pf(-exp2f(-5.0f - (float)h)) * LOG2E;
    const float cd = exp2f(64.0f * l2g);
    const bf16* base = F.proj + (size_t)(b * SEQ) * INW + h * HD;
    const unsigned lb = (unsigned)(size_t)F.lds;
    LAS unsigned char* L = F.lds;
    LAS float* gnp = (LAS float*)(L + R_GNP); LAS float* gns = (LAS float*)(L + R_GNS);
    f32x4 st[8];
#pragma unroll
    for (int dt = 0; dt < 8; ++dt) st[dt] = (f32x4){0.f, 0.f, 0.f, 0.f};
    const int srow = tid >> 4, sch = tid & 15;
    float kdec[2];
#pragma unroll
    for (int i = 0; i < 2; ++i) kdec[i] = exp2f((float)(63 - (srow + 32 * i)) * l2g);
    u32x4 rq[2], rk[2], rv[2];
#define RT_GLOAD(n) do { _Pragma("unroll") for (int i = 0; i < 2; ++i) { const bf16* p = base + (size_t)(64 * (n) + srow + 32 * i) * INW + 8 * sch; \
        rq[i] = *(const u32x4*)(p + C_RQ); rk[i] = *(const u32x4*)(p + C_RK); rv[i] = *(const u32x4*)(p + C_RV); } } while (0)
    const int n_first = 4 * seg, n_end = 4 * seg + 4;
    const int tq4 = l15 >> 2, tp = lane & 3;
    const unsigned trl = lb + 320u * (8 * g + tq4) + 32u * (g & 1) + 8u * tp, trv = trl + R_VT + 32u * w;
    const unsigned rwl = 272u * l15 + 16u * g;
#define RT_IMM(c, ks, t) (10240 * (ks) + 1280 * (t) + 32 * (c))
#define RT_UPDATE(bufoff) do { _Pragma("unroll") for (int dt = 0; dt < 8; ++dt) st[dt] = st[dt] * cd; \
        _Pragma("unroll") for (int ks = 0; ks < 2; ++ks) { \
            u32x2 v0, v1; MX_TRRD(v0, trv, (bufoff) + RT_IMM(0, ks, 0)); MX_TRRD(v1, trv, (bufoff) + RT_IMM(0, ks, 1)); \
            u32x2 k0[8], k1[8]; \
            _Pragma("unroll") for (int dt = 0; dt < 8; ++dt) { MX_TRRD(k0[dt], trl, (bufoff) + R_KD + RT_IMM(dt, ks, 0)); MX_TRRD(k1[dt], trl, (bufoff) + R_KD + RT_IMM(dt, ks, 1)); } \
            asm volatile("s_waitcnt lgkmcnt(0)" : "+v"(v0), "+v"(v1), "+v"(k0[0]), "+v"(k0[1]), "+v"(k0[2]), "+v"(k0[3]), "+v"(k0[4]), "+v"(k0[5]), "+v"(k0[6]), "+v"(k0[7]), \
                         "+v"(k1[0]), "+v"(k1[1]), "+v"(k1[2]), "+v"(k1[3]), "+v"(k1[4]), "+v"(k1[5]), "+v"(k1[6]), "+v"(k1[7]) :: "memory"); \
            const bf16x8 vb = frag(v0, v1); \
            _Pragma("unroll") for (int dt = 0; dt < 8; ++dt) st[dt] = __builtin_amdgcn_mfma_f32_16x16x32_bf16(frag(k0[dt], k1[dt]), vb, st[dt], 0, 0, 0); } } while (0)
#define RT_KDPACK(dst, src, kdv) do { dst.x = pg8::cvt_pk_bf16(bf2f(src.x & 0xffffu) * kdv, bf2f(src.x >> 16) * kdv); dst.y = pg8::cvt_pk_bf16(bf2f(src.y & 0xffffu) * kdv, bf2f(src.y >> 16) * kdv); \
        dst.z = pg8::cvt_pk_bf16(bf2f(src.z & 0xffffu) * kdv, bf2f(src.z >> 16) * kdv); dst.w = pg8::cvt_pk_bf16(bf2f(src.w & 0xffffu) * kdv, bf2f(src.w >> 16) * kdv); } while (0)
#define RT_PLOAD(PK, PV, n) do { _Pragma("unroll") for (int i = 0; i < 2; ++i) { const bf16* p = base + (size_t)(64 * (n) + srow + 32 * i) * INW + 8 * sch; PK[i] = *(const u32x4*)(p + C_RK); PV[i] = *(const u32x4*)(p + C_RV); } } while (0)
#define RT_PSTORE(PK, PV, bufoff) do { _Pragma("unroll") for (int i = 0; i < 2; ++i) { const unsigned ot = offtr(srow + 32 * i, 16 * sch); *(LAS u32x4*)(L + (bufoff) + R_VT + ot) = PV[i]; \
            u32x4 kd; const float kdv = kdec[i]; RT_KDPACK(kd, PK[i], kdv); *(LAS u32x4*)(L + (bufoff) + R_KD + ot) = kd; } } while (0)
    f32x4* lbase = (f32x4*)F.retL + tid;
    if constexpr (MODE == 0) {
        u32x4 pk0[2], pv0[2], pk1[2], pv1[2];
        RT_PLOAD(pk0, pv0, n_first); RT_PLOAD(pk1, pv1, n_first + 1);
        __syncthreads();
        for (int n = n_first; n < n_end; n += 2) {
            RT_PSTORE(pk0, pv0, 0); if (n + 2 < n_end) RT_PLOAD(pk0, pv0, n + 2);
            __syncthreads();
            RT_UPDATE(0);
            RT_PSTORE(pk1, pv1, 40960); if (n + 3 < n_end) RT_PLOAD(pk1, pv1, n + 3);
            __syncthreads();
            RT_UPDATE(40960);
        }
#pragma unroll
        for (int dt = 0; dt < 8; ++dt) lbase[((size_t)unit * 8 + dt) * NTHREADS] = st[dt];
        __syncthreads();
        if (tid == 0) { __threadfence(); __hip_atomic_store(F.ctl + CW_RETF + unit, 1u, __ATOMIC_RELEASE, __HIP_MEMORY_SCOPE_AGENT); }
        return;
    }
    RT_GLOAD(n_first);
    if (seg > 0) {
        if (tid == 0)
            for (int j = 0; j < seg; ++j) while (__hip_atomic_load(F.ctl + CW_RETF + unit - seg + j, __ATOMIC_ACQUIRE, __HIP_MEMORY_SCOPE_AGENT) == 0u) __builtin_amdgcn_s_sleep(4);
        __syncthreads();
        const float cd4 = exp2f(256.0f * l2g); float coef = 1.0f;
#pragma unroll 2
        for (int j = seg - 1; j >= 0; --j) {
            f32x4 t[8];
#pragma unroll
            for (int dt = 0; dt < 8; ++dt) t[dt] = lbase[((size_t)(unit - seg + j) * 8 + dt) * NTHREADS];
#pragma unroll
            for (int dt = 0; dt < 8; ++dt) st[dt] = st[dt] + t[dt] * coef;
            coef *= cd4;
        }
    }
#undef RT_PLOAD
#undef RT_PSTORE
    for (int n = n_first; n < n_end; ++n) {
        constexpr bool full = true;
        __syncthreads();
#pragma unroll
        for (int i = 0; i < 2; ++i) {
            const unsigned o = offrw(srow + 32 * i, 16 * sch), ot = offtr(srow + 32 * i, 16 * sch);
            *(LAS u32x4*)(L + R_QT + o) = rq[i]; *(LAS u32x4*)(L + R_KT + o) = rk[i]; *(LAS u32x4*)(L + R_VT + ot) = rv[i];
            u32x4 kd; const float kdv = kdec[i]; RT_KDPACK(kd, rk[i], kdv);
            *(LAS u32x4*)(L + R_KD + ot) = kd;
        }
        if (full) {
#pragma unroll
            for (int dt = 0; dt < 8; ++dt) { u32x2 o; o.x = pg8::cvt_pk_bf16(st[dt][0], st[dt][1]); o.y = pg8::cvt_pk_bf16(st[dt][2], st[dt][3]);
                *(LAS u32x2*)(L + R_ST + offrw(16 * w + l15, 32 * dt + 8 * g)) = o; }
        }
        if (n + 1 < n_end) RT_GLOAD(n + 1);
        unsigned short gq[4][4];
#pragma unroll
        for (int mt = 0; mt < 4; ++mt)
#pragma unroll
            for (int r = 0; r < 4; ++r) gq[mt][r] = base[(size_t)(64 * n + 16 * mt + 4 * g + r) * INW + C_RG + 16 * w + l15];
        __syncthreads();
        if (full) {
            {
                const int jt = w & 3, ctb = 2 * (w >> 2);
                f32x4 sc[2] = {(f32x4){0.f, 0.f, 0.f, 0.f}, (f32x4){0.f, 0.f, 0.f, 0.f}};
#pragma unroll
                for (int s = 0; s < 4; ++s) { const bf16x8 a = *(const LAS bf16x8*)(L + R_KT + 4352 * jt + rwl + 64 * s);
#pragma unroll
                    for (int cc = 0; cc < 2; ++cc) { const bf16x8 bq = *(const LAS bf16x8*)(L + R_QT + 4352 * (ctb + cc) + rwl + 64 * s); sc[cc] = __builtin_amdgcn_mfma_f32_16x16x32_bf16(a, bq, sc[cc], 0, 0, 0); } }
#pragma unroll
                for (int cc = 0; cc < 2; ++cc) { const int c = 16 * (ctb + cc) + l15, j0 = 16 * jt + 4 * g; float pvv[4];
#pragma unroll
                    for (int r = 0; r < 4; ++r) pvv[r] = sc[cc][r] * __builtin_amdgcn_exp2f(fabsf((float)(c - (j0 + r))) * l2g);
                    u32x2 o; o.x = pg8::cvt_pk_bf16(pvv[0], pvv[1]); o.y = pg8::cvt_pk_bf16(pvv[2], pvv[3]);
                    *(LAS u32x2*)(L + R_PT + c * R_PPITCH + j0 * 2) = o; }
            }
            __syncthreads();
            f32x4 oi[4], oc[4];
#pragma unroll
            for (int mt = 0; mt < 4; ++mt) { oi[mt] = (f32x4){0.f, 0.f, 0.f, 0.f}; oc[mt] = (f32x4){0.f, 0.f, 0.f, 0.f}; }
#pragma unroll
            for (int s = 0; s < 2; ++s) {
                u32x2 v0, v1; MX_TRRD(v0, trv, RT_IMM(0, s, 0)); MX_TRRD(v1, trv, RT_IMM(0, s, 1));
                asm volatile("s_waitcnt lgkmcnt(0)" : "+v"(v0), "+v"(v1) :: "memory");
                const bf16x8 vb = frag(v0, v1);
#pragma unroll
                for (int mt = 0; mt < 4; ++mt) { const bf16x8 pa = *(const LAS bf16x8*)(L + R_PT + (l15 + 16 * mt) * R_PPITCH + (32 * s + 8 * g) * 2); oi[mt] = __builtin_amdgcn_mfma_f32_16x16x32_bf16(pa, vb, oi[mt], 0, 0, 0); }
            }
#pragma unroll
            for (int s = 0; s < 4; ++s) {
                const bf16x8 sb_ = *(const LAS bf16x8*)(L + R_ST + 4352 * w + rwl + 64 * s);
#pragma unroll
                for (int mt = 0; mt < 4; ++mt) { const bf16x8 qa = *(const LAS bf16x8*)(L + R_QT + 4352 * mt + rwl + 64 * s); oc[mt] = __builtin_amdgcn_mfma_f32_16x16x32_bf16(qa, sb_, oc[mt], 0, 0, 0); }
            }
#pragma unroll
            for (int mt = 0; mt < 4; ++mt)
#pragma unroll
                for (int r = 0; r < 4; ++r) { const int c = 16 * mt + 4 * g + r; const float o = oi[mt][r] + __builtin_amdgcn_exp2f((float)(c + 1) * l2g) * oc[mt][r]; oi[mt][r] = o;
                    const float s1 = row16_sum(o), s2 = row16_sum(o * o);
                    if (l15 == 0) { gnp[(c * 8 + w) * 2] = s1; gnp[(c * 8 + w) * 2 + 1] = s2; } }
            __syncthreads();
            if (tid < 64) { float s1 = 0.f, s2 = 0.f;
#pragma unroll
                for (int ww = 0; ww < 8; ++ww) { s1 += gnp[(tid * 8 + ww) * 2]; s2 += gnp[(tid * 8 + ww) * 2 + 1]; }
                const float mu = s1 * (1.0f / 128.0f), var = fmaxf(s2 * (1.0f / 128.0f) - mu * mu, 0.f);
                gns[tid * 2] = mu; gns[tid * 2 + 1] = 1.0f / sqrtf(var + GN_EPS); }
            __syncthreads();
            {   const int e = 16 * w + l15; const float gain = F.gn_gain[h * HD + e];
#pragma unroll
                for (int mt = 0; mt < 4; ++mt)
#pragma unroll
                    for (int r = 0; r < 4; ++r) { const int c = 16 * mt + 4 * g + r; const size_t row = (size_t)(b * SEQ + 64 * n + c);
                        const float gv = bf2f(gq[mt][r]);
                        const float y = (oi[mt][r] - gns[c * 2]) * gns[c * 2 + 1] * gain * (gv * __builtin_amdgcn_rcpf(1.0f + __builtin_amdgcn_exp2f(-gv * LOG2E)));
                        F.mixin[row * D + 1024 + h * HD + e] = (bf16)f2bf(y); }
            }
        }
        RT_UPDATE(0);
    }
#undef RT_GLOAD
#undef RT_IMM
#undef RT_UPDATE
#undef RT_KDPACK
}
}

__device__ __forceinline__ void ph_mixer(Frame& F) {
    const int gc = role_split(F) ? W_MIX : F.G;
    if (F.bid < gc) {
        for (int u = F.bid; u < NB * NH * 8; u += gc) mx::ret_unit<0>(F, u);
        int k = 0;
        for (int u = F.bid; u < NB * NH * 8; u += gc, ++k) mx::sb_unit(F, ((k & 1) && gc % 8 == 0) ? u : (u ^ 7));
        for (int u = F.bid; u < NB * NH * 8; u += gc) mx::ret_unit<1>(F, u);
    } else conv_role(F, I_R1, I_R2, gc);
}

__device__ __forceinline__ void ln_row(float4 (&v)[8], const float* gain, const float* bias, int lane) {
    float s = 0.f;
#pragma unroll
    for (int j = 0; j < 8; ++j) s += (v[j].x + v[j].y) + (v[j].z + v[j].w);
    const float mean = wave_sum(s) * (1.0f / D);
    float q = 0.f;
#pragma unroll
    for (int j = 0; j < 8; ++j) { v[j].x -= mean; v[j].y -= mean; v[j].z -= mean; v[j].w -= mean; q += (v[j].x * v[j].x + v[j].y * v[j].y) + (v[j].z * v[j].z + v[j].w * v[j].w); }
    const float rstd = 1.0f / sqrtf(wave_sum(q) * (1.0f / D) + LN_EPS);
#pragma unroll
    for (int j = 0; j < 8; ++j) { const float4 g = *(const float4*)(gain + 4 * lane + 256 * j), bb = *(const float4*)(bias + 4 * lane + 256 * j);
        v[j].x = v[j].x * rstd * g.x + bb.x; v[j].y = v[j].y * rstd * g.y + bb.y; v[j].z = v[j].z * rstd * g.z + bb.z; v[j].w = v[j].w * rstd * g.w + bb.w; }
}


constexpr int XT_PITCH = 2052;
constexpr int RPART_OFF = 134144, RLOG_OFF = 150528;
__device__ __forceinline__ void ph_ln1_router(Frame& F) {
    LAS float* xt = (LAS float*)F.lds;
    LAS float* part = (LAS float*)(F.lds + RPART_OFF);
    LAS float* lgt = (LAS float*)(F.lds + RLOG_OFF);
    const int lane = F.lane, w = F.wave;
    const float* bp = F.w_router + (size_t)(256 * w + (lane >> 4)) * NE + (lane & 15);
    f32x4 va[8], vb[8];
#define LN1_ISSUE(uu) do { const f32x4* xr0 = (const f32x4*)(F.x1 + (size_t)((uu) * 16 + 2 * w) * D) + lane; const f32x4* xr1 = xr0 + D / 4; \
        _Pragma("unroll") for (int j = 0; j < 8; ++j) { va[j] = xr0[64 * j]; vb[j] = xr1[64 * j]; } } while (0)
    int u = F.bid;
    if (u < T / 16) LN1_ISSUE(u);
    for (; u < T / 16; u += F.G) {
        const int m0 = u * 16;
        __syncthreads();
        {
            float sa = 0.f, sb = 0.f;
#pragma unroll
            for (int j = 0; j < 8; ++j) { sa += (va[j][0] + va[j][1]) + (va[j][2] + va[j][3]); sb += (vb[j][0] + vb[j][1]) + (vb[j][2] + vb[j][3]); }
            const float ma = wave_sum(sa) * (1.0f / D), mb = wave_sum(sb) * (1.0f / D);
            float qa = 0.f, qb = 0.f;
#pragma unroll
            for (int j = 0; j < 8; ++j) { va[j] = va[j] - ma; vb[j] = vb[j] - mb; const f32x4 a2 = va[j] * va[j], b2 = vb[j] * vb[j]; qa += (a2[0] + a2[1]) + (a2[2] + a2[3]); qb += (b2[0] + b2[1]) + (b2[2] + b2[3]); }
            const float ra = 1.0f / sqrtf(wave_sum(qa) * (1.0f / D) + LN_EPS), rb = 1.0f / sqrtf(wave_sum(qb) * (1.0f / D) + LN_EPS);
            unsigned* ob0 = (unsigned*)(F.x1q + (size_t)(m0 + 2 * w) * D) + lane; unsigned* ob1 = ob0 + D / 4;
            pg8::u32x2* oh0 = (pg8::u32x2*)(F.x1h + (size_t)(m0 + 2 * w) * D) + lane; pg8::u32x2* oh1 = oh0 + D / 4;
#pragma unroll
            for (int j = 0; j < 8; ++j) {
                const f32x4 gj = *(const f32x4*)(F.ln1_g + 4 * lane + 256 * j), bj = *(const f32x4*)(F.ln1_b + 4 * lane + 256 * j);
                const f32x4 ya = va[j] * ra * gj + bj, yb = vb[j] * rb * gj + bj;
                { pg8::u32x2 ha, hb; ha.x = pg8::cvt_pk_bf16(ya[0], ya[1]); ha.y = pg8::cvt_pk_bf16(ya[2], ya[3]); hb.x = pg8::cvt_pk_bf16(yb[0], yb[1]); hb.y = pg8::cvt_pk_bf16(yb[2], yb[3]); oh0[64 * j] = ha; oh1[64 * j] = hb; }
                int o = __builtin_amdgcn_cvt_pk_fp8_f32(ya[0], ya[1], 0, false); o = __builtin_amdgcn_cvt_pk_fp8_f32(ya[2], ya[3], o, true); ob0[64 * j] = (unsigned)o;
                o = __builtin_amdgcn_cvt_pk_fp8_f32(yb[0], yb[1], 0, false); o = __builtin_amdgcn_cvt_pk_fp8_f32(yb[2], yb[3], o, true); ob1[64 * j] = (unsigned)o;
                *(LAS f32x4*)(xt + (2 * w) * XT_PITCH + 4 * lane + 256 * j) = ya; *(LAS f32x4*)(xt + (2 * w + 1) * XT_PITCH + 4 * lane + 256 * j) = yb; }
        }
        {
            float rb0[64], rb1[64];
            __builtin_amdgcn_sched_barrier(0);
            const float* bq = bp; asm volatile("" : "+v"(bq));
#pragma unroll
            for (int ks = 0; ks < 64; ++ks) { rb0[ks] = bq[(size_t)(4 * ks) * NE]; rb1[ks] = bq[(size_t)(4 * ks) * NE + 16]; }
            __syncthreads();
            f32x4 c0 = {0.f, 0.f, 0.f, 0.f}, c1 = {0.f, 0.f, 0.f, 0.f};
            const LAS float* ap = xt + (lane & 15) * XT_PITCH + 256 * w + (lane >> 4);
#pragma unroll
            for (int ks = 0; ks < 64; ++ks) {
                const float a = ap[4 * ks];
                c0 = __builtin_amdgcn_mfma_f32_16x16x4f32(a, rb0[ks], c0, 0, 0, 0);
                c1 = __builtin_amdgcn_mfma_f32_16x16x4f32(a, rb1[ks], c1, 0, 0, 0);
                if ((ks & 7) == 7) __builtin_amdgcn_sched_barrier(0);
            }
            __builtin_amdgcn_sched_barrier(0);
            if (u + F.G < T / 16) LN1_ISSUE(u + F.G);
#pragma unroll
            for (int g = 0; g < 4; ++g) { part[(w * 16 + 4 * (lane >> 4) + g) * 32 + (lane & 15)] = c0[g]; part[(w * 16 + 4 * (lane >> 4) + g) * 32 + 16 + (lane & 15)] = c1[g]; }
        }
        __syncthreads();
        {   const int r = F.tid >> 5, e = F.tid & 31; float s = F.b_router[e];
#pragma unroll
            for (int ww = 0; ww < 8; ++ww) s += part[(ww * 16 + r) * 32 + e];
            lgt[r * 33 + e] = s; }
        __syncthreads();
        if (F.tid < 16) {
            const LAS float* lg = lgt + F.tid * 33; const int t = m0 + F.tid;
            int i0 = -1, i1 = -1, i2 = -1, i3 = -1; float v0 = 0.f, v1 = 0.f, v2 = 0.f, v3 = 0.f;
#pragma unroll 1
            for (int k = 0; k < TOPK; ++k) {
                float best = -3.0e38f; int bi = 0;
                for (int e = 0; e < NE; ++e) { const float v = lg[e]; const bool used = (e == i0) | (e == i1) | (e == i2); if (!used && v > best) { best = v; bi = e; } }
                if (k == 0) { i0 = bi; v0 = best; } else if (k == 1) { i1 = bi; v1 = best; } else if (k == 2) { i2 = bi; v2 = best; } else { i3 = bi; v3 = best; }
            }
            const float e0 = 1.0f, e1 = expf(v1 - v0), e2 = expf(v2 - v0), e3 = expf(v3 - v0), inv = 1.0f / (e0 + e1 + e2 + e3);
            const int p0 = (int)atomicAdd(F.ctl + CW_CNT + i0, 1u), p1 = (int)atomicAdd(F.ctl + CW_CNT + i1, 1u), p2 = (int)atomicAdd(F.ctl + CW_CNT + i2, 1u), p3 = (int)atomicAdd(F.ctl + CW_CNT + i3, 1u);
            *(int4*)(F.toke + (size_t)t * 4) = make_int4(i0, i1, i2, i3);
            *(int4*)(F.tokp + (size_t)t * 4) = make_int4(p0, p1, p2, p3);
            *(float4*)(F.tokg + (size_t)t * 4) = make_float4(e0 * inv, e1 * inv, e2 * inv, e3 * inv);
            F.sorted[(size_t)i0 * T + p0] = t; F.sorted[(size_t)i1 * T + p1] = t; F.sorted[(size_t)i2 * T + p2] = t; F.sorted[(size_t)i3 * T + p3] = t;
        }
    }
}
#undef LN1_ISSUE

__device__ __forceinline__ ExpTab build_exptab(Frame& F, int TM, int lds_off) {
    ExpTab X; X.cnt = (LAS int*)(F.lds + lds_off); X.off = X.cnt + 32; X.tpre = X.off + 32;
    __syncthreads();
    if (F.wave == 0) {
        const int lane = F.lane;
        const int c = lane < NE ? (int)__hip_atomic_load(F.ctl + CW_CNT + lane, __ATOMIC_RELAXED, __HIP_MEMORY_SCOPE_AGENT) : 0;
        int so = c, st = (c + TM - 1) / TM; const int t0 = st;
#pragma unroll
        for (int d = 1; d < 32; d <<= 1) { const int a = __shfl_up(so, d), bq = __shfl_up(st, d); if (lane >= d) { so += a; st += bq; } }
        if (lane < NE) { X.cnt[lane] = c; X.off[lane] = so - c; X.tpre[lane] = st - t0; }
        if (lane == NE - 1) X.tpre[NE] = st;
    }
    __syncthreads();
    return X;
}

struct FinMeta { const pg8::u32x2 *y0, *y1, *y2, *y3, *xr; float4 tg; };
struct FinRaw { pg8::u32x2 x[4], a[4], b[4], c[4], d[4]; };
__device__ __forceinline__ void ph_final(Frame& F) {
    ExpTab X = build_exptab(F, 256, EXPTAB_OFF);
    LAS float* gl = (LAS float*)F.lds; LAS float* bl = gl + D;
    for (int i = F.tid; i < D; i += NTHREADS) { gl[i] = F.ln2_g[i]; bl[i] = F.ln2_b[i]; }
    __syncthreads();
    const int gw = F.bid * NWAVES + F.wave, NGW = F.G * NWAVES, lane = F.lane;
#define FIN_META(M, m) do { const int4 te = *(const int4*)(F.toke + (size_t)(m) * 4), tp = *(const int4*)(F.tokp + (size_t)(m) * 4); M.tg = *(const float4*)(F.tokg + (size_t)(m) * 4); \
        M.y0 = (const pg8::u32x2*)(F.ybuf + (size_t)(X.off[te.x] + tp.x) * D) + lane; M.y1 = (const pg8::u32x2*)(F.ybuf + (size_t)(X.off[te.y] + tp.y) * D) + lane; \
        M.y2 = (const pg8::u32x2*)(F.ybuf + (size_t)(X.off[te.z] + tp.z) * D) + lane; M.y3 = (const pg8::u32x2*)(F.ybuf + (size_t)(X.off[te.w] + tp.w) * D) + lane; M.xr = (const pg8::u32x2*)(F.x1h + (size_t)(m) * D) + lane; } while (0)
#define FIN_LOAD(R, M, hf) do { _Pragma("unroll") for (int j = 0; j < 4; ++j) { R.x[j] = __builtin_nontemporal_load(M.xr + 64 * (4 * (hf) + j)); R.a[j] = __builtin_nontemporal_load(M.y0 + 64 * (4 * (hf) + j)); R.b[j] = __builtin_nontemporal_load(M.y1 + 64 * (4 * (hf) + j)); R.c[j] = __builtin_nontemporal_load(M.y2 + 64 * (4 * (hf) + j)); R.d[j] = __builtin_nontemporal_load(M.y3 + 64 * (4 * (hf) + j)); } } while (0)
#define FIN_COMB(R, M, hf) do { _Pragma("unroll") for (int j = 0; j < 4; ++j) { const pg8::u32x2 xh = R.x[j]; const float4 xv = make_float4(bf2f(xh.x & 0xffffu), bf2f(xh.x >> 16), bf2f(xh.y & 0xffffu), bf2f(xh.y >> 16)); const pg8::u32x2 a = R.a[j], b = R.b[j], c = R.c[j], d = R.d[j]; const float4 tg = M.tg; float4 o; \
        o.x = ALPHA * xv.x + tg.x * bf2f(a.x & 0xffffu) + tg.y * bf2f(b.x & 0xffffu) + tg.z * bf2f(c.x & 0xffffu) + tg.w * bf2f(d.x & 0xffffu); \
        o.y = ALPHA * xv.y + tg.x * bf2f(a.x >> 16) + tg.y * bf2f(b.x >> 16) + tg.z * bf2f(c.x >> 16) + tg.w * bf2f(d.x >> 16); \
        o.z = ALPHA * xv.z + tg.x * bf2f(a.y & 0xffffu) + tg.y * bf2f(b.y & 0xffffu) + tg.z * bf2f(c.y & 0xffffu) + tg.w * bf2f(d.y & 0xffffu); \
        o.w = ALPHA * xv.w + tg.x * bf2f(a.y >> 16) + tg.y * bf2f(b.y >> 16) + tg.z * bf2f(c.y >> 16) + tg.w * bf2f(d.y >> 16); v[4 * (hf) + j] = o; } } while (0)
    int m = gw; if (m >= T) return;
    FinMeta Mc, Mn; FinRaw A, B; float4 v[8];
    FIN_META(Mc, m); FIN_LOAD(A, Mc, 0);
    for (; m < T; m += NGW) {
        FIN_LOAD(B, Mc, 1);
        FIN_COMB(A, Mc, 0);
        const int mn = m + NGW; const bool more = mn < T;
        if (more) { FIN_META(Mn, mn); FIN_LOAD(A, Mn, 0); }
        FIN_COMB(B, Mc, 1);
        float s = 0.f;
#pragma unroll
        for (int j = 0; j < 8; ++j) s += (v[j].x + v[j].y) + (v[j].z + v[j].w);
        const float mean = wave_sum(s) * (1.0f / D);
        float q = 0.f;
#pragma unroll
        for (int j = 0; j < 8; ++j) { v[j].x -= mean; v[j].y -= mean; v[j].z -= mean; v[j].w -= mean; q += (v[j].x * v[j].x + v[j].y * v[j].y) + (v[j].z * v[j].z + v[j].w * v[j].w); }
        const float rstd = 1.0f / sqrtf(wave_sum(q) * (1.0f / D) + LN_EPS);
        f32x4* o = (f32x4*)(F.out + (size_t)m * D) + lane;
#pragma unroll
        for (int j = 0; j < 8; ++j) { const f32x4 g = *(const LAS f32x4*)(gl + 4 * lane + 256 * j), bb = *(const LAS f32x4*)(bl + 4 * lane + 256 * j);
            __builtin_nontemporal_store((f32x4){v[j].x * rstd * g[0] + bb[0], v[j].y * rstd * g[1] + bb[1], v[j].z * rstd * g[2] + bb[2], v[j].w * rstd * g[3] + bb[3]}, o + 64 * j); }
        Mc = Mn;
    }
#undef FIN_META
#undef FIN_LOAD
#undef FIN_COMB
}

constexpr int LDS_BYTES = 155648;
constexpr int MISC_OFF = 132096;

__global__ void __launch_bounds__(NTHREADS, 2) fwd(Args args) {
    extern __shared__ __attribute__((aligned(16))) unsigned char lds[];
    Frame F;
    F.lds = (LAS unsigned char*)lds;
    F.tid = threadIdx.x; F.lane = F.tid & 63; F.wave = __builtin_amdgcn_readfirstlane(F.tid >> 6);
    F.G = gridDim.x; F.bid = blockIdx.x;
    unsigned char* ws = args.ws;
    F.x = args.in[0]; F.w_in = args.in[1]; F.gn_gain = args.in[2]; F.w_out = args.in[3]; F.ln1_g = args.in[4]; F.ln1_b = args.in[5];
    F.w_router = args.in[6]; F.b_router = args.in[7]; F.w_gu = args.in[8]; F.b_gu = args.in[9]; F.w_down = args.in[10]; F.b_down = args.in[11];
    F.ln2_g = args.in[12]; F.ln2_b = args.in[13]; F.out = args.out;
    F.ctl = (unsigned*)(ws + WS_CTL);
    F.ropec = (float*)(ws + WS_ROPE); F.ropes = F.ropec + SEQ * 64;
    F.xb = (bf16*)(ws + WS_XB); F.proj = (bf16*)(ws + WS_PROJ); F.mixin = (bf16*)(ws + WS_MIXIN); F.x1 = (float*)(ws + WS_X1); F.x1q = ws + WS_X1B; F.x1h = (bf16*)(ws + WS_X1H); F.retL = (float*)(ws + WS_RETL);
    F.logits = (float*)(ws + WS_LOGITS); F.toke = (int*)(ws + WS_TOKE); F.tokp = (int*)(ws + WS_TOKP); F.tokg = (float*)(ws + WS_TOKG); F.sorted = (int*)(ws + WS_SORTED);
    F.hq = ws + WS_H; F.ybuf = (bf16*)(ws + WS_Y);
    F.winT = (bf16*)(ws + WS_WIN_T); F.woutT = (bf16*)(ws + WS_WOUT_T); F.wguQ = ws + WS_WGU_T; F.wdQ = ws + WS_WD_T;

    volatile LAS unsigned* MISC = (volatile LAS unsigned*)(F.lds + MISC_OFF);
    if (F.tid < 32) MISC[F.tid] = 0u;
    __syncthreads();
    const int lo = args.ph_lo, hi = args.ph_hi;
    XcdBarrier bar; bar.bar = F.ctl + CW_BAR; bar.x = 0; bar.st = nullptr;
    if (hi - lo > 1) bar = xcd_barrier_post(F.ctl + CW_BAR, MISC + 8);
#define IN(k) (lo <= (k) && (k) < hi && ((F.lane = lane_now()), (F.tid = F.wave * 64 + F.lane), true))
#define SEAM(k) do { if (IN(k) && IN((k) + 1)) xcd_barrier(bar, F.wave == 0 && lane_now() == 0); } while (0)
    if (IN(0)) { ph_prologue(F); ph_prologue_w(F); }
    SEAM(0);
    if (IN(1)) ph_proj(F);
    SEAM(1);
    if (IN(2)) ph_mixer(F);
    SEAM(2);
    if (IN(3)) ph_outproj(F);
    SEAM(3);
    if (IN(4)) ph_ln1_router(F);
    SEAM(4);
    if (IN(5)) ph_moe_up(F);
    SEAM(5);
    if (IN(6)) ph_moe_down(F);
    SEAM(6);
    if (IN(7)) ph_final(F);
#undef IN
#undef SEAM
}
}

extern "C" void kernel_launch(void* const* d_in, const int* in_sizes, int n_in, void* d_out, int out_size, void* d_ws, size_t ws_size, hipStream_t stream) {
    static int grid = 0;
    if (grid == 0) {
        if (n_in != 14 || out_size != T * D || ws_size < WS_END) { fprintf(stderr, "kernel_launch: unexpected shapes (n_in %d out %d ws %zu)\n", n_in, out_size, ws_size); grid = -1; return; }
        int dev = 0, cus = 0, per_cu = 0;
        if (hipGetDevice(&dev) != hipSuccess || hipDeviceGetAttribute(&cus, hipDeviceAttributeMultiprocessorCount, dev) != hipSuccess) { grid = -1; return; }
        if (hipFuncSetAttribute((const void*)fwd, hipFuncAttributeMaxDynamicSharedMemorySize, LDS_BYTES) != hipSuccess) { fprintf(stderr, "kernel_launch: hipFuncSetAttribute failed\n"); grid = -1; return; }
        if (hipOccupancyMaxActiveBlocksPerMultiprocessor(&per_cu, (const void*)fwd, NTHREADS, LDS_BYTES) != hipSuccess || per_cu < 1) fprintf(stderr, "kernel_launch: occupancy query says %d\n", per_cu);
        (void)hipGetLastError();
        grid = cus;
    }
    if (grid < 0) return;
    (void)hipMemsetAsync((char*)d_ws + WS_CTL, 0, CTL_ZERO_BYTES, stream);
    Args a{};
    for (int i = 0; i < 14; ++i) a.in[i] = (const float*)d_in[i];
    a.out = (float*)d_out; a.ws = (unsigned char*)d_ws;
    constexpr int NL = MK_N_LAUNCHES;
    for (int li = 0; li < NL; ++li) {
        a.ph_lo = (NL == 1) ? 0 : li; a.ph_hi = (NL == 1) ? NPHASE : li + 1;
        hipLaunchKernelGGL(fwd, dim3(grid), dim3(NTHREADS), LDS_BYTES, stream, a);
    }
}
```

```cpp
#include <hip/hip_runtime.h>
#include <cstdio>
#include <cstdint>

#ifndef MK_N_LAUNCHES
#define MK_N_LAUNCHES 1
#endif

namespace {
constexpr int NB = 4, SEQ = 2048, T = NB * SEQ, D = 2048, INW = 7168, NE = 32, TOPK = 4, FF = 2048, HD = 128, NH = 8;
constexpr int C_SBQ = 0, C_SBK = 1024, C_SBV = 2048, C_RQ = 3072, C_RK = 4096, C_RV = 5120, C_RG = 6144;
constexpr float LN_EPS = 1e-5f, GN_EPS = 1e-5f, ALPHA = 1.189207115002721f;
constexpr float QSCALE = 0.08838834764831845f;
constexpr int NPHASE = 8;
constexpr int NTHREADS = 512, NWAVES = 8;

constexpr size_t MiB = 1u << 20;
constexpr size_t WS_CTL = 0, CTL_ZERO_BYTES = 1 * MiB;
constexpr size_t WS_ROPE = 1 * MiB;
constexpr size_t WS_XB = 2 * MiB;
constexpr size_t WS_PROJ = 34 * MiB;
constexpr size_t WS_MIXIN = 146 * MiB;
constexpr size_t WS_X1 = 178 * MiB;
constexpr size_t WS_X1B = 242 * MiB;
constexpr size_t WS_LOGITS = 274 * MiB;
constexpr size_t WS_TOKE = 275 * MiB;
constexpr size_t WS_TOKP = WS_TOKE + 128 * 1024;
constexpr size_t WS_TOKG = WS_TOKP + 128 * 1024;
constexpr size_t WS_SORTED = 276 * MiB;
constexpr size_t WS_H = 278 * MiB;
constexpr size_t WS_Y = 408 * MiB;
constexpr size_t WS_WIN_T = 544 * MiB;
constexpr size_t WS_WOUT_T = 572 * MiB;
constexpr size_t WS_WGU_T = 580 * MiB;
constexpr size_t WS_WD_T = 1092 * MiB;
constexpr size_t WS_X1H = 1348 * MiB;
constexpr size_t WS_END = 1380 * MiB;
constexpr int CW_CNT = 64;
constexpr int CW_BAR = 4096;

typedef unsigned short bf16;
typedef float f32x4 __attribute__((ext_vector_type(4)));
#define LAS __attribute__((address_space(3)))

__device__ __forceinline__ float bf2f(unsigned v) { return __uint_as_float(v << 16); }
__device__ __forceinline__ unsigned f2bf(float f) { unsigned u = __float_as_uint(f); return (u + 0x7fffu + ((u >> 16) & 1u)) >> 16; }
__device__ __forceinline__ unsigned pk2(float lo, float hi) { return f2bf(lo) | (f2bf(hi) << 16); }
__device__ __forceinline__ int lane_now() { int l; asm volatile("v_mbcnt_lo_u32_b32 %0, -1, 0\n\tv_mbcnt_hi_u32_b32 %0, -1, %0" : "=v"(l)); return l; }
__device__ __forceinline__ float wave_sum(float v) {
#pragma unroll
    for (int o = 1; o < 64; o <<= 1) v += __shfl_xor(v, o);
    return v;
}

#define XB_TMO      128
#define XB_XCNT(j)  (256  + 64 * (j))
#define XB_XSUB(j)  (1280 + 64 * (j))
#define XB_XGEN(j)  (2304 + 64 * (j))
#define XB_TOP      3328
#define XB_TOPGEN   3392
#define XCD_BAR_WORDS 3456
#define XB_SPIN_CAP (1u << 18)
__device__ __forceinline__ unsigned xb_ld(unsigned* p)              { return __hip_atomic_load(p, __ATOMIC_RELAXED, __HIP_MEMORY_SCOPE_AGENT); }
__device__ __forceinline__ unsigned xb_add(unsigned* p, unsigned v) { return __hip_atomic_fetch_add(p, v, __ATOMIC_RELAXED, __HIP_MEMORY_SCOPE_AGENT); }
__device__ __forceinline__ unsigned xb_xcc_id() { return (unsigned)__builtin_amdgcn_s_getreg((3 << 11) | 20) & 0xFu; }
#define XB_SPIN(cond, bar) do { unsigned _sp = 0; while (cond) { __builtin_amdgcn_s_sleep(1); \
    if ((++_sp & 255u) == 0u) { if (xb_ld(&(bar)[XB_TMO])) break; if (_sp > XB_SPIN_CAP) { atomicAdd(&(bar)[XB_TMO], 1u); break; } } } } while (0)
struct XcdBarrier { unsigned* bar; unsigned x; volatile LAS unsigned* st; };
__device__ __forceinline__ XcdBarrier xcd_barrier_post(unsigned* bar, volatile LAS unsigned* st) {
    XcdBarrier b; b.bar = bar; b.x = xb_xcc_id(); b.st = st;
    if (threadIdx.x == 0) (void)xb_add(&bar[XB_XCNT(b.x)], 1u);
    return b;
}
__device__ __forceinline__ void xcd_barrier_complete(unsigned* bar, unsigned x, unsigned& nloc, unsigned& nx) {
    const unsigned G = gridDim.x * gridDim.y * gridDim.z;
    unsigned sum, cnt, mine, sp = 0u;
    for (;;) {
        sum = 0u; cnt = 0u; mine = 0u;
#pragma unroll
        for (unsigned j = 0; j < 16; ++j) { const unsigned c = xb_ld(&bar[XB_XCNT(j)]); sum += c; cnt += (c > 0u) ? 1u : 0u; mine = (j == x) ? c : mine; }
        if (sum == G) break;
        __builtin_amdgcn_s_sleep(1);
        if ((++sp & 255u) == 0u) { if (xb_ld(&bar[XB_TMO])) break; if (sp > XB_SPIN_CAP) { atomicAdd(&bar[XB_TMO], 1u); break; } }
    }
    nloc = mine > 0u ? mine : 1u; nx = cnt > 0u ? cnt : 1u;
}
__device__ __forceinline__ void xcd_barrier(const XcdBarrier& b, bool leader) {
    asm volatile("s_waitcnt vmcnt(0)" ::: "memory");
    __syncthreads();
    if (leader) {
        unsigned* bar = b.bar;
        __builtin_amdgcn_s_waitcnt(0);
        unsigned nloc = b.st[0], nx = b.st[1];
        if (nloc == 0u) { xcd_barrier_complete(bar, b.x, nloc, nx); b.st[0] = nloc; b.st[1] = nx; }
        const unsigned old = xb_add(&bar[XB_XSUB(b.x)], 1u);
        const unsigned gen = old / nloc;
        if (old + 1u == (gen + 1u) * nloc) {
            __builtin_amdgcn_fence(__ATOMIC_RELEASE, "agent");
            asm volatile("s_waitcnt vmcnt(0)" ::: "memory");
            const unsigned og = xb_add(&bar[XB_TOP], 1u);
            const unsigned tg = og / nx;
            if (og + 1u == (tg + 1u) * nx) xb_add(&bar[XB_TOPGEN], 1u);
            else XB_SPIN(xb_ld(&bar[XB_TOPGEN]) == tg, bar);
            __builtin_amdgcn_fence(__ATOMIC_ACQUIRE, "agent");
            xb_add(&bar[XB_XGEN(b.x)], 1u);
            asm volatile("s_waitcnt vmcnt(0)" ::: "memory");
        } else {
            XB_SPIN(xb_ld(&bar[XB_XGEN(b.x)]) == gen, bar);
            __builtin_amdgcn_fence(__ATOMIC_ACQUIRE, "agent");
            asm volatile("s_waitcnt vmcnt(0)" ::: "memory");
        }
    }
    __syncthreads();
}

struct Args {
    const float* in[14];
    float* out;
    unsigned char* ws;
    int ph_lo, ph_hi;
};
struct Frame {
    LAS unsigned char* lds;
    int tid, lane, wave, G, bid;
    const float *x, *w_in, *gn_gain, *w_out, *ln1_g, *ln1_b, *w_router, *b_router, *w_gu, *b_gu, *w_down, *b_down, *ln2_g, *ln2_b;
    float* out;
    unsigned* ctl;
    float *ropec, *ropes;
    bf16 *xb, *proj, *mixin, *ybuf, *winT, *woutT;
    unsigned char *x1q, *hq, *wguQ, *wdQ;
    bf16* x1h;
    float *x1, *logits, *tokg;
    int *toke, *tokp, *sorted;
};


namespace pg8 {
typedef short bf16x8 __attribute__((ext_vector_type(8)));
typedef unsigned u32x4 __attribute__((ext_vector_type(4)));
typedef unsigned u32x2 __attribute__((ext_vector_type(2)));
constexpr int BM = 256, BK = 64, HALF = 128, HTB = HALF * BK * 2, STAGE_BYTES = 8 * HTB, NXCD = 8, WGM = 8;
constexpr int KD = 2048;
__device__ __forceinline__ int lds_byte(int r, int c) { const int st = (r >> 4) * 2 + (c >> 5), rr = r & 15, cc = c & 31, ob = rr * 64 + cc * 2; return st * 1024 + (ob ^ (((ob >> 9) & 1) << 5)); }
__device__ __forceinline__ void stage_rc(int b, int& R, int& C) { const int st = b / 1024, sb = b % 1024, swz = sb ^ (((sb >> 9) & 1) << 5); R = (st >> 1) * 16 + swz / 64; C = (st & 1) * 32 + (swz % 64) / 2; }
__device__ __forceinline__ unsigned cvt_pk_bf16(float lo, float hi) { unsigned r; asm volatile("v_cvt_pk_bf16_f32 %0, %1, %2" : "=v"(r) : "v"(lo), "v"(hi)); return r; }

struct Unit { const char *a0, *a1, *b0, *b1; int e0, e1, e2, e3; };

typedef int i32x8 __attribute__((ext_vector_type(8)));
typedef int i32x4 __attribute__((ext_vector_type(4)));
__device__ __forceinline__ i32x8 cat8(bf16x8 lo, bf16x8 hi) { return __builtin_shufflevector(__builtin_bit_cast(i32x4, lo), __builtin_bit_cast(i32x4, hi), 0, 1, 2, 3, 4, 5, 6, 7); }
template <class Epi, class Sched, bool GATHER, int KDV = KD, bool F8 = false>
__device__ __forceinline__ void gemm_phase(LAS unsigned char* lds, const Sched& S, const Epi& E, int wid) {
    const int lane = lane_now(), tid = wid * 64 + lane, wr = wid >> 2, wc = wid & 3, fr = lane & 15, fq = lane >> 4;
    constexpr int K = KDV, nt = K / BK;
    unsigned voffA[2][2], voffB[2]; int sR0, sC0;
    stage_rc(tid * 16, sR0, sC0);
#pragma unroll
    for (int i = 0; i < 2; ++i) { voffB[i] = (unsigned)((sR0 + 64 * i) * K + sC0) * 2u; voffA[0][i] = voffB[i]; voffA[1][i] = voffB[i]; }
    constexpr size_t kstep = (size_t)(BK * 2);
    const unsigned ldsw = (unsigned)wid * 1024u;
    const int aoff = lds_byte(wr * 64 + fr, fq * 8), boff = lds_byte(wc * 32 + fr, fq * 8);
#define PG8_SA(b, h) (((b) * 2 + (h)) * HTB)
#define PG8_SB(b, h) ((4 + (b) * 2 + (h)) * HTB)
#define PG8_STAGE(bufoff, gbase, voff) do { _Pragma("unroll") for (int _i = 0; _i < 2; ++_i) \
        __builtin_amdgcn_global_load_lds((const unsigned*)((const char*)(gbase) + (voff)[_i]), (LAS unsigned*)(lds + (bufoff) + ldsw + _i * 8192), 16, 0, 0); } while (0)
#define PG8_LDA(dst, b, h) do { _Pragma("unroll") for (int m = 0; m < 4; ++m) { if constexpr (F8) { dst##8[m].lo = *(const LAS i32x4*)(lds + PG8_SA(b, h) + aoff + m * 2048); dst##8[m].hi = *(const LAS i32x4*)(lds + PG8_SA(b, h) + aoff + m * 2048 + 1024); } \
        else { _Pragma("unroll") for (int k = 0; k < 2; ++k) dst[m][k] = *(const LAS bf16x8*)(lds + PG8_SA(b, h) + aoff + m * 2048 + k * 1024); } } } while (0)
#define PG8_LDB(dst, b, h) do { _Pragma("unroll") for (int n = 0; n < 2; ++n) { if constexpr (F8) { dst##8[n].lo = *(const LAS i32x4*)(lds + PG8_SB(b, h) + boff + n * 2048); dst##8[n].hi = *(const LAS i32x4*)(lds + PG8_SB(b, h) + boff + n * 2048 + 1024); } \
        else { _Pragma("unroll") for (int k = 0; k < 2; ++k) dst[n][k] = *(const LAS bf16x8*)(lds + PG8_SB(b, h) + boff + n * 2048 + k * 1024); } } } while (0)
#define PG8_MMA(ai, bj, At, Bt) do { __builtin_amdgcn_s_setprio(1); _Pragma("unroll") for (int m = 0; m < 4; ++m) _Pragma("unroll") for (int n = 0; n < 2; ++n) { \
        if constexpr (F8) acc[ai][bj][m][n] = __builtin_amdgcn_mfma_scale_f32_16x16x128_f8f6f4(Bt##8[n], At##8[m], acc[ai][bj][m][n], 0, 0, 0, 0x7f7f7f7f, 0, 0x7f7f7f7f); \
        else { _Pragma("unroll") for (int k = 0; k < 2; ++k) acc[ai][bj][m][n] = __builtin_amdgcn_mfma_f32_16x16x32_bf16(Bt[n][k], At[m][k], acc[ai][bj][m][n], 0, 0, 0); } } __builtin_amdgcn_s_setprio(0); } while (0)
#define PG8_WAIT_V(n) asm volatile("s_waitcnt vmcnt(" #n ")" ::: "memory")
#define PG8_WAIT_L(n) asm volatile("s_waitcnt lgkmcnt(" #n ")" ::: "memory")
#define PG8_BAR __builtin_amdgcn_s_barrier()
#define PG8_SCHED __builtin_amdgcn_sched_barrier(0)
    Unit cur, nxt; int ui = 0;
    if (!S.next(0, cur)) return;
    if constexpr (GATHER) S.voff(cur, sR0, sC0, voffA);
    f32x4 acc[2][2][4][2];
#pragma unroll
    for (int a = 0; a < 2; ++a)
#pragma unroll
        for (int b = 0; b < 2; ++b)
#pragma unroll
            for (int m = 0; m < 4; ++m)
#pragma unroll
                for (int n = 0; n < 2; ++n) acc[a][b][m][n] = (f32x4){0.f, 0.f, 0.f, 0.f};
    bf16x8 At[F8 ? 1 : 4][2], B0[F8 ? 1 : 2][2], B1[F8 ? 1 : 2][2];
    i32x8 At8[F8 ? 4 : 1], B08[F8 ? 2 : 1], B18[F8 ? 2 : 1];
    PG8_STAGE(PG8_SB(0, 0), cur.b0, voffB); PG8_STAGE(PG8_SB(0, 1), cur.b1, voffB); PG8_STAGE(PG8_SA(0, 0), cur.a0, voffA[0]); PG8_STAGE(PG8_SA(0, 1), cur.a1, voffA[1]);
    if (wr == 1) PG8_BAR;
    PG8_WAIT_V(2); PG8_BAR;
    PG8_STAGE(PG8_SB(1, 0), cur.b0 + kstep, voffB); PG8_STAGE(PG8_SA(1, 0), cur.a0 + kstep, voffA[0]); PG8_STAGE(PG8_SB(1, 1), cur.b1 + kstep, voffB);
    PG8_WAIT_V(6); PG8_BAR;
    for (;;) {
        const bool has_next = S.next(ui + 1, nxt);
        if (!has_next) nxt = cur;
        for (int t = 0; t < nt; t += 2) {
            const bool last = (t == nt - 2);
            asm volatile("" : "+v"(voffA[0][0]), "+v"(voffA[0][1]), "+v"(voffA[1][0]), "+v"(voffA[1][1]), "+v"(voffB[0]), "+v"(voffB[1]));
            const char* a1h1 = cur.a1 + (size_t)(t + 1) * kstep;
            const char* a2h0 = last ? nxt.a0 : cur.a0 + (size_t)(t + 2) * kstep; const char* a2h1 = last ? nxt.a1 : cur.a1 + (size_t)(t + 2) * kstep;
            const char* b2h0 = last ? nxt.b0 : cur.b0 + (size_t)(t + 2) * kstep; const char* b2h1 = last ? nxt.b1 : cur.b1 + (size_t)(t + 2) * kstep;
            const char* a3h0 = a2h0 + kstep; const char* b3h0 = b2h0 + kstep; const char* b3h1 = b2h1 + kstep;
            PG8_LDB(B0, 0, 0); PG8_LDB(B1, 0, 1); PG8_SCHED; PG8_LDA(At, 0, 0); PG8_STAGE(PG8_SA(1, 1), a1h1, voffA[1]);
            PG8_WAIT_V(8); PG8_WAIT_L(0); PG8_BAR;
            if constexpr (GATHER) { if (last) S.voff(nxt, sR0, sC0, voffA); }
            PG8_MMA(0, 0, At, B0); PG8_MMA(0, 1, At, B1); PG8_BAR; PG8_SCHED;
            PG8_LDA(At, 0, 1); PG8_STAGE(PG8_SB(0, 0), b2h0, voffB); PG8_STAGE(PG8_SB(0, 1), b2h1, voffB); PG8_STAGE(PG8_SA(0, 0), a2h0, voffA[0]);
            PG8_WAIT_V(8); PG8_WAIT_L(0); PG8_BAR; PG8_MMA(1, 0, At, B0); PG8_MMA(1, 1, At, B1); PG8_BAR; PG8_SCHED;
            PG8_LDB(B0, 1, 0); PG8_LDB(B1, 1, 1); PG8_SCHED; PG8_LDA(At, 1, 0); PG8_STAGE(PG8_SA(0, 1), a2h1, voffA[1]);
            PG8_WAIT_V(8); PG8_WAIT_L(0); PG8_BAR; PG8_MMA(0, 0, At, B0); PG8_MMA(0, 1, At, B1); PG8_BAR; PG8_SCHED;
            PG8_LDA(At, 1, 1); PG8_STAGE(PG8_SB(1, 0), b3h0, voffB); PG8_STAGE(PG8_SB(1, 1), b3h1, voffB); PG8_STAGE(PG8_SA(1, 0), a3h0, voffA[0]);
            PG8_WAIT_V(8); PG8_WAIT_L(0); PG8_BAR; PG8_MMA(1, 0, At, B0); PG8_MMA(1, 1, At, B1); PG8_BAR; PG8_SCHED;
        }
        if (wr == 0) PG8_BAR;
        { const int l2 = lane_now();
          E(acc, cur, wr, wc, l2 & 15, l2 >> 4); }
        if (!has_next) break;
#pragma unroll
        for (int a = 0; a < 2; ++a)
#pragma unroll
            for (int b = 0; b < 2; ++b)
#pragma unroll
                for (int m = 0; m < 4; ++m)
#pragma unroll
                    for (int n = 0; n < 2; ++n) acc[a][b][m][n] = (f32x4){0.f, 0.f, 0.f, 0.f};
        cur = nxt; ++ui;
        if (wr == 1) PG8_BAR;
    }
    PG8_WAIT_V(0);
    PG8_BAR;
#undef PG8_SA
#undef PG8_SB
#undef PG8_STAGE
#undef PG8_LDA
#undef PG8_LDB
#undef PG8_MMA
#undef PG8_WAIT_V
#undef PG8_WAIT_L
#undef PG8_BAR
#undef PG8_SCHED
}
}

constexpr int EXPTAB_OFF = 133120;
struct ExpTab { LAS int* cnt; LAS int* off; LAS int* tpre; };
struct DenseSched {
    const char* A; const char* Bt; int nM, nN, nwg, G, c, gm;
    __device__ __forceinline__ void init(const void* A_, const void* Bt_, int M, int N, int G_, int c_, int gm_ = 8) { A = (const char*)A_; Bt = (const char*)Bt_; nM = M / 256; nN = N / 256; nwg = nM * nN; G = G_; c = c_; gm = gm_; }
    __device__ __forceinline__ bool next(int i, pg8::Unit& u) const {
        const long L = (long)i * G + c; if (L >= nwg) return false;
        int wgid = (int)L; { const int q = nwg / 8, r = nwg % 8, xcd = wgid % 8, off = wgid / 8; wgid = (xcd < r ? xcd * (q + 1) : r * (q + 1) + (xcd - r) * q) + off; }
        const int nig = gm * nN, gid = wgid / nig, fm = gid * gm, gsz = (nM - fm) < gm ? (nM - fm) : gm;
        const int pm = fm + ((wgid % nig) % gsz), pn = (wgid % nig) / gsz;
        constexpr size_t hstep = (size_t)128 * pg8::KD * 2;
        u.a0 = A + (size_t)pm * 2 * hstep; u.a1 = u.a0 + hstep; u.b0 = Bt + (size_t)pn * 2 * hstep; u.b1 = u.b0 + hstep; u.e0 = pm; u.e1 = pn; u.e2 = 0; u.e3 = 0; return true;
    }
    __device__ __forceinline__ void voff(const pg8::Unit&, int, int, unsigned (&)[2][2]) const {}
};
struct MoeSched {
    ExpTab X; const char* A; const char* Bt; const int* sorted; int NT, G, v; bool up;
    static constexpr int KQ = 1024;
    __device__ __forceinline__ bool next(int i, pg8::Unit& u) const {
#define RFL(x) __builtin_amdgcn_readfirstlane(x)
        const int L = i * G + v; if (L >= RFL(X.tpre[NE]) * NT) return false;
        const int ln = lane_now();
        const int e = __builtin_popcountll(__ballot(ln < NE && X.tpre[(ln & 31) + 1] * NT <= L));
        const int tp0 = RFL(X.tpre[e]), ntl = RFL(X.tpre[e + 1]) - tp0, r = L - tp0 * NT, nt = r / ntl, mt = r - nt * ntl;
        constexpr size_t hstep = (size_t)128 * KQ * 2;
        u.e0 = e; u.e1 = mt; u.e2 = nt; u.e3 = RFL(X.cnt[e]);
        u.b0 = Bt + (size_t)(e * NT + nt) * 2 * hstep; u.b1 = u.b0 + hstep;
        if (up) { u.a0 = A; u.a1 = A; }
        else { u.a0 = A + (size_t)(RFL(X.off[e]) + mt * 256) * KQ * 2; u.a1 = u.a0 + hstep; }
#undef RFL
        return true;
    }
    __device__ __forceinline__ void voff(const pg8::Unit& u, int R0, int C0, unsigned (&v)[2][2]) const {
        if (up) { const int* srt = sorted + (size_t)u.e0 * T;
#pragma unroll
            for (int h = 0; h < 2; ++h)
#pragma unroll
                for (int i = 0; i < 2; ++i) { int p = u.e1 * 256 + h * 128 + 64 * i + R0; p = p < u.e3 ? p : 0; v[h][i] = (unsigned)(srt[p] * KQ + C0) * 2u; } }
        else {
#pragma unroll
            for (int h = 0; h < 2; ++h)
#pragma unroll
                for (int i = 0; i < 2; ++i) v[h][i] = (unsigned)((64 * i + R0) * KQ + C0) * 2u; }
    }
};

struct EpiProj {
    bf16* proj; const float* rc; const float* rs;
    __device__ __forceinline__ void operator()(const f32x4 (&acc)[2][2][4][2], const pg8::Unit& u, int wr, int wc, int fr, int fq) const {
        const int row0 = u.e0 * 256 + wr * 64 + fr, i0 = 16 * wc + 4 * fq;
#pragma unroll
        for (int bj = 0; bj < 2; ++bj) {
            const int hb = u.e1 * 256 + bj * 128;
            const bool rot = (hb >= C_RQ && hb < C_RV);
            const float sc = (hb < C_SBK || (hb >= C_RK && hb < C_RV)) ? QSCALE : 1.0f;
#pragma unroll
            for (int ai = 0; ai < 2; ++ai)
#pragma unroll
                for (int m = 0; m < 4; ++m) {
                    const int row = row0 + ai * 128 + m * 16;
                    f32x4 v0 = acc[ai][bj][m][0], v1 = acc[ai][bj][m][1];
                    if (rot) { const int pos = row & (SEQ - 1); const f32x4 c = *(const f32x4*)(rc + pos * 64 + i0), s = *(const f32x4*)(rs + pos * 64 + i0);
                        const f32x4 o0 = v0 * c - v1 * s, o1 = v0 * s + v1 * c; v0 = o0; v1 = o1; }
                    v0 = v0 * sc; v1 = v1 * sc;
                    pg8::u32x2 w; w.x = pg8::cvt_pk_bf16(v0[0], v0[1]); w.y = pg8::cvt_pk_bf16(v0[2], v0[3]);
                    *(pg8::u32x2*)(proj + (size_t)row * INW + hb + i0) = w;
                    w.x = pg8::cvt_pk_bf16(v1[0], v1[1]); w.y = pg8::cvt_pk_bf16(v1[2], v1[3]);
                    *(pg8::u32x2*)(proj + (size_t)row * INW + hb + 64 + i0) = w;
                }
        }
    }
};
struct EpiOut {
    const float* x; float* x1;
    __device__ __forceinline__ void operator()(const f32x4 (&acc)[2][2][4][2], const pg8::Unit& u, int wr, int wc, int fr, int fq) const {
        const int row0 = u.e0 * 256 + wr * 64 + fr, col0 = u.e1 * 256 + wc * 32 + 4 * fq;
#pragma unroll
        for (int ai = 0; ai < 2; ++ai)
#pragma unroll
            for (int m = 0; m < 4; ++m) { const size_t o = (size_t)(row0 + ai * 128 + m * 16) * D + col0;
#pragma unroll
                for (int bj = 0; bj < 2; ++bj)
#pragma unroll
                    for (int n = 0; n < 2; ++n) { const f32x4 xv = *(const f32x4*)(x + o + bj * 128 + n * 16); *(f32x4*)(x1 + o + bj * 128 + n * 16) = xv * ALPHA + acc[ai][bj][m][n]; } }
    }
};
constexpr float WQ_SCALE = 64.0f, WQ_INV = 1.0f / 64.0f;
struct EpiUp {
    unsigned char* hb; const float* bgu; ExpTab X;
    __device__ __forceinline__ void operator()(const f32x4 (&acc)[2][2][4][2], const pg8::Unit& u, int wr, int wc, int fr, int fq) const {
        const int e = u.e0, cnt = u.e3, off = X.off[e], f0 = u.e2 * 128 + 32 * wc + 8 * fq;
        const float* bg = bgu + (size_t)e * 2 * FF;
        f32x4 bgv[2], buv[2];
#pragma unroll
        for (int n = 0; n < 2; ++n) { bgv[n] = *(const f32x4*)(bg + f0 + 4 * n); buv[n] = *(const f32x4*)(bg + FF + f0 + 4 * n); }
#pragma unroll
        for (int ai = 0; ai < 2; ++ai)
#pragma unroll
            for (int m = 0; m < 4; ++m) {
                const int p = u.e1 * 256 + ai * 128 + wr * 64 + m * 16 + fr;
                float hv[8];
#pragma unroll
                for (int n = 0; n < 2; ++n) { const f32x4 g = acc[ai][0][m][n] * WQ_INV + bgv[n], uu = acc[ai][1][m][n] * WQ_INV + buv[n];
#pragma unroll
                    for (int j = 0; j < 4; ++j) { const float gate = fminf(g[j], 7.0f), up = fminf(fmaxf(uu[j], -7.0f), 7.0f);
                        hv[4 * n + j] = (up + 1.0f) * gate * __builtin_amdgcn_rcpf(1.0f + __builtin_amdgcn_exp2f(-1.702f * 1.4426950408889634f * gate)); } }
                if (p < cnt) { pg8::u32x2 w; int t0 = __builtin_amdgcn_cvt_pk_fp8_f32(hv[0], hv[1], 0, false); t0 = __builtin_amdgcn_cvt_pk_fp8_f32(hv[2], hv[3], t0, true);
                    int t1 = __builtin_amdgcn_cvt_pk_fp8_f32(hv[4], hv[5], 0, false); t1 = __builtin_amdgcn_cvt_pk_fp8_f32(hv[6], hv[7], t1, true); w.x = (unsigned)t0; w.y = (unsigned)t1;
                    *(pg8::u32x2*)(hb + (size_t)(off + p) * FF + f0) = w; }
            }
    }
};
struct EpiDown {
    bf16* yb; const float* bdn; ExpTab X;
    __device__ __forceinline__ void operator()(const f32x4 (&acc)[2][2][4][2], const pg8::Unit& u, int wr, int wc, int fr, int fq) const {
        const int e = u.e0, cnt = u.e3, off = X.off[e], c0 = u.e2 * 256 + 32 * wc + 8 * fq;
        const float* bd = bdn + (size_t)e * D;
#pragma unroll
        for (int bj = 0; bj < 2; ++bj) {
            const f32x4 b0 = *(const f32x4*)(bd + c0 + bj * 128), b1 = *(const f32x4*)(bd + c0 + bj * 128 + 4);
#pragma unroll
            for (int ai = 0; ai < 2; ++ai)
#pragma unroll
                for (int m = 0; m < 4; ++m) {
                    const int p = u.e1 * 256 + ai * 128 + wr * 64 + m * 16 + fr;
                    const f32x4 v0 = acc[ai][bj][m][0] * WQ_INV + b0, v1 = acc[ai][bj][m][1] * WQ_INV + b1;
                    pg8::u32x4 w; w.x = pg8::cvt_pk_bf16(v0[0], v0[1]); w.y = pg8::cvt_pk_bf16(v0[2], v0[3]); w.z = pg8::cvt_pk_bf16(v1[0], v1[1]); w.w = pg8::cvt_pk_bf16(v1[2], v1[3]);
                    if (p < cnt) *(pg8::u32x4*)(yb + (size_t)(off + p) * D + c0 + bj * 128) = w;
                }
        }
    }
};

struct EpiMoe {
    bool up; EpiUp eu; EpiDown ed;
    __device__ __forceinline__ void operator()(const f32x4 (&acc)[2][2][4][2], const pg8::Unit& u, int wr, int wc, int fr, int fq) const { if (up) eu(acc, u, wr, wc, fr, fq); else ed(acc, u, wr, wc, fr, fq); }
};
__device__ __forceinline__ void ph_prologue(Frame& F) {
    const size_t gt = (size_t)F.bid * NTHREADS + F.tid, gs = (size_t)F.G * NTHREADS;
    const float4* x4 = (const float4*)F.x; uint2* o2 = (uint2*)F.xb;
    for (size_t i = gt; i < (size_t)T * D / 4; i += gs) { const float4 v = x4[i]; uint2 o; o.x = pk2(v.x, v.y); o.y = pk2(v.z, v.w); o2[i] = o; }
    for (size_t i = gt; i < (size_t)SEQ * 64; i += gs) {
        const int pos = (int)(i >> 6), f = (int)(i & 63);
        const float invf = exp2f(-(float)f * (13.287712379549449f / 64.0f));
        const float ang = (float)pos * invf;
        double rev = (double)ang * 0.15915494309189535; rev -= floor(rev);
        F.ropec[i] = __builtin_amdgcn_cosf((float)rev); F.ropes[i] = __builtin_amdgcn_sinf((float)rev);
    }
}


__device__ __forceinline__ int rho8(int c) { return 32 * (c >> 5) + 16 * ((c >> 2) & 1) + 4 * ((c >> 3) & 3) + (c & 3); }
constexpr int I_IN = (D / 64) * (INW / 32), I_OUT = (D / 64) * (D / 32), I_GU = (D / 64) * (2 * FF / 32), I_DN = (FF / 64) * (D / 32);
constexpr int I_DENSE = I_IN + I_OUT, I_ALL = I_DENSE + NE * (I_GU + I_DN);
#ifndef W_PROJ
#define W_PROJ 128
#endif
#ifndef W_MIX
#define W_MIX 128
#endif
#ifndef W_OUT
#define W_OUT 256
#endif
#ifndef CONV_F0
#define CONV_F0 0.0
#endif
#ifndef CONV_F1
#define CONV_F1 0.6
#endif
#ifndef W_LN1
#define W_LN1 128
#endif
#ifndef CONV_F3
#define CONV_F3 0.91
#endif
#ifndef CONV_F2
#define CONV_F2 0.91
#endif
constexpr int I_MOE = I_ALL - I_DENSE;
constexpr int I_R0 = I_DENSE + (int)(I_MOE * (double)(CONV_F0)), I_R1 = I_DENSE + (int)(I_MOE * (double)(CONV_F1)), I_R2 = I_DENSE + (int)(I_MOE * (double)(CONV_F2)), I_R3 = I_DENSE + (int)(I_MOE * (double)(CONV_F3));
struct CItem { const float* wp; void* WT; int N, n0, k0, kind; };
__device__ __forceinline__ CItem conv_decode(const Frame& F, int it, int lane) {
    CItem c; int r = it; const float* W; int kb, nb;
    if (r < I_IN) { W = F.w_in; c.N = INW; c.WT = F.winT; c.kind = 0; }
    else if ((r -= I_IN) < I_OUT) { W = F.w_out; c.N = D; c.WT = F.woutT; c.kind = 1; }
    else { r -= I_OUT; const int e = r / (I_GU + I_DN); r -= e * (I_GU + I_DN);
        if (r < I_GU) { W = F.w_gu + (size_t)e * D * 2 * FF; c.N = 2 * FF; c.WT = F.wguQ + (size_t)e * 2 * FF * D; c.kind = 2; }
        else { r -= I_GU; W = F.w_down + (size_t)e * FF * D; c.N = D; c.WT = F.wdQ + (size_t)e * D * FF; c.kind = 3; } }
    const int nblk = c.N / 32; kb = r / nblk; nb = r - kb * nblk; c.k0 = 64 * kb; c.n0 = 32 * nb;
    c.wp = W + (size_t)(c.k0 + (lane >> 3)) * c.N + c.n0 + 4 * (lane & 7);
    return c;
}
__device__ __forceinline__ void conv_load(const CItem& c, f32x4 (&v)[8]) {
#pragma unroll
    for (int i = 0; i < 8; ++i) v[i] = __builtin_nontemporal_load((const f32x4*)(c.wp + (size_t)(8 * i) * c.N));
}
__device__ __forceinline__ int conv_row(int kind, int n) {
    const int c = n & 127;
    if (kind == 0) return (n & ~127) + 32 * ((c >> 4) & 3) + 16 * (c >> 6) + (c & 15);
    if (kind == 1) return n;
    if (kind == 2) { const int half = n >> 11, f = n & 2047; return (f >> 7) * 256 + half * 128 + rho8(f & 127); }
    return (n & ~127) + rho8(c);
}
__device__ __forceinline__ void conv_store(const CItem& c, const f32x4 (&v)[8], LAS float* scr, int lane) {
    {   LAS float* wq = scr + (lane >> 3) * 33 + 4 * (lane & 7);
#pragma unroll
        for (int i = 0; i < 8; ++i) { wq[(8 * i) * 33 + 0] = v[i][0]; wq[(8 * i) * 33 + 1] = v[i][1]; wq[(8 * i) * 33 + 2] = v[i][2]; wq[(8 * i) * 33 + 3] = v[i][3]; } }
    asm volatile("s_waitcnt lgkmcnt(0)" ::: "memory");
    if (c.kind < 2) {
        const int ch = lane >> 3;
#pragma unroll
        for (int j = 0; j < 4; ++j) { const int n = (lane & 7) + 8 * j; const LAS float* sp = scr + (8 * ch) * 33 + n;
            pg8::u32x4 o; o.x = pg8::cvt_pk_bf16(sp[0 * 33], sp[1 * 33]); o.y = pg8::cvt_pk_bf16(sp[2 * 33], sp[3 * 33]); o.z = pg8::cvt_pk_bf16(sp[4 * 33], sp[5 * 33]); o.w = pg8::cvt_pk_bf16(sp[6 * 33], sp[7 * 33]);
            *(pg8::u32x4*)((bf16*)c.WT + (size_t)conv_row(c.kind, c.n0 + n) * D + c.k0 + 8 * ch) = o; }
    } else {
        const int ch = lane >> 4;
#pragma unroll
        for (int j = 0; j < 2; ++j) { const int n = (lane & 15) + 16 * j; const LAS float* sp = scr + (16 * ch) * 33 + n; pg8::u32x4 o;
#pragma unroll
            for (int d = 0; d < 4; ++d) { int t = __builtin_amdgcn_cvt_pk_fp8_f32(sp[(4 * d) * 33] * WQ_SCALE, sp[(4 * d + 1) * 33] * WQ_SCALE, 0, false);
                t = __builtin_amdgcn_cvt_pk_fp8_f32(sp[(4 * d + 2) * 33] * WQ_SCALE, sp[(4 * d + 3) * 33] * WQ_SCALE, t, true); o[d] = (unsigned)t; }
            __builtin_nontemporal_store(o, (pg8::u32x4*)((unsigned char*)c.WT + (size_t)conv_row(c.kind, c.n0 + n) * D + c.k0 + 16 * ch)); }
    }
    asm volatile("s_waitcnt lgkmcnt(0)" ::: "memory");
}
__device__ __forceinline__ CItem conv_decode_moe(const Frame& F, int it, int lane) {
    CItem c; int r = it - I_DENSE; const int e = r / (I_GU + I_DN); r -= e * (I_GU + I_DN);
    const bool gu = r < I_GU; const int r2 = gu ? r : r - I_GU, sh = gu ? 7 : 6;
    const int kb = r2 >> sh, nb = r2 & ((1 << sh) - 1);
    c.N = gu ? 2 * FF : D; c.kind = gu ? 2 : 3; c.k0 = 64 * kb; c.n0 = 32 * nb;
    const float* W = gu ? F.w_gu + (size_t)e * D * 2 * FF : F.w_down + (size_t)e * FF * D;
    c.WT = gu ? (void*)(F.wguQ + (size_t)e * 2 * FF * D) : (void*)(F.wdQ + (size_t)e * D * FF);
    c.wp = W + (size_t)(c.k0 + (lane >> 3)) * c.N + c.n0 + 4 * (lane & 7);
    return c;
}
__device__ __forceinline__ void conv_store_moe(const CItem& c, const f32x4 (&v)[8], LAS float* scr, int lane) {
    {   LAS float* wq = scr + (lane >> 3) * 33 + 4 * (lane & 7);
#pragma unroll
        for (int i = 0; i < 8; ++i) { wq[(8 * i) * 33 + 0] = v[i][0]; wq[(8 * i) * 33 + 1] = v[i][1]; wq[(8 * i) * 33 + 2] = v[i][2]; wq[(8 * i) * 33 + 3] = v[i][3]; } }
    asm volatile("s_waitcnt lgkmcnt(0)" ::: "memory");
    const int ch = lane >> 4;
#pragma unroll
    for (int j = 0; j < 2; ++j) { const int n = (lane & 15) + 16 * j, nn = c.n0 + n; const LAS float* sp = scr + (16 * ch) * 33 + n; pg8::u32x4 o;
#pragma unroll
        for (int d = 0; d < 4; ++d) { int t = __builtin_amdgcn_cvt_pk_fp8_f32(sp[(4 * d) * 33] * WQ_SCALE, sp[(4 * d + 1) * 33] * WQ_SCALE, 0, false);
            t = __builtin_amdgcn_cvt_pk_fp8_f32(sp[(4 * d + 2) * 33] * WQ_SCALE, sp[(4 * d + 3) * 33] * WQ_SCALE, t, true); o[d] = (unsigned)t; }
        const int f = nn & 2047, row2 = (f >> 7) * 256 + (nn >> 11) * 128 + rho8(f & 127), row3 = (nn & ~127) + rho8(nn & 127);
        __builtin_nontemporal_store(o, (pg8::u32x4*)((unsigned char*)c.WT + (size_t)(c.kind == 2 ? row2 : row3) * D + c.k0 + 16 * ch)); }
    asm volatile("s_waitcnt lgkmcnt(0)" ::: "memory");
}
__device__ __forceinline__ void conv_items(Frame& F, int first, int last, int gw, int NGW) {
    LAS float* scr = (LAS float*)(F.lds + F.wave * 16384);
    const int lane = lane_now();
    int it = first + gw; if (it >= last) return;
    CItem c0, c1, c2, c3; f32x4 v0[8], v1[8], v2[8], v3[8];
#define CV_LOAD(c, v, idx) do { if ((idx) < last) { c = conv_decode(F, (idx), lane); conv_load(c, v); } } while (0)
#define CV_STORE(c, v, idx) do { if ((idx) < last) conv_store(c, v, scr, lane); } while (0)
#define CV_LOADU(c, v, idx) do { c = conv_decode_moe(F, (idx), lane); conv_load(c, v); } while (0)
    if (first >= I_DENSE && it + 6 * NGW < last) {
        CV_LOADU(c0, v0, it); CV_LOADU(c1, v1, it + NGW); CV_LOADU(c2, v2, it + 2 * NGW);
        for (; it + 6 * NGW < last; it += 4 * NGW) {
            CV_LOADU(c3, v3, it + 3 * NGW); conv_store_moe(c0, v0, scr, lane);
            CV_LOADU(c0, v0, it + 4 * NGW); conv_store_moe(c1, v1, scr, lane);
            CV_LOADU(c1, v1, it + 5 * NGW); conv_store_moe(c2, v2, scr, lane);
            CV_LOADU(c2, v2, it + 6 * NGW); conv_store_moe(c3, v3, scr, lane);
        }
    } else { CV_LOAD(c0, v0, it); CV_LOAD(c1, v1, it + NGW); CV_LOAD(c2, v2, it + 2 * NGW); }
#undef CV_LOADU
    for (; it < last; it += 4 * NGW) {
        CV_LOAD(c3, v3, it + 3 * NGW); CV_STORE(c0, v0, it);
        CV_LOAD(c0, v0, it + 4 * NGW); CV_STORE(c1, v1, it + NGW);
        CV_LOAD(c1, v1, it + 5 * NGW); CV_STORE(c2, v2, it + 2 * NGW);
        CV_LOAD(c2, v2, it + 6 * NGW); CV_STORE(c3, v3, it + 3 * NGW);
    }
#undef CV_LOAD
#undef CV_STORE
}
__device__ __forceinline__ void conv_role(Frame& F, int first, int last, int w) { conv_items(F, first, last, (F.bid - w) * NWAVES + F.wave, (F.G - w) * NWAVES); }
__device__ __forceinline__ bool role_split(const Frame& F) { return F.G == 256; }
__device__ __forceinline__ void ph_prologue_w(Frame& F) { conv_items(F, 0, role_split(F) ? I_R0 : I_ALL, F.bid * NWAVES + F.wave, F.G * NWAVES); }

__device__ __forceinline__ int vcu_of(const Frame& F) { return (F.G % 8 == 0) ? (F.bid % 8) * (F.G / 8) + F.bid / 8 : F.bid; }
__device__ __forceinline__ void ph_proj(Frame& F) {
    const int gc = role_split(F) ? W_PROJ : F.G;
    if (F.bid < gc) {
        DenseSched S; S.init(F.xb, F.winT, T, INW, gc, F.bid, gc == 128 ? 4 : 8);
        EpiProj E{F.proj, F.ropec, F.ropes};
        pg8::gemm_phase<EpiProj, DenseSched, false>(F.lds, S, E, F.wave);
    } else conv_role(F, I_R0, I_R1, gc);
}
__device__ __forceinline__ void ph_outproj(Frame& F) {
    const int gc = role_split(F) ? W_OUT : F.G;
    if (F.bid < gc) {
        DenseSched S; S.init(F.mixin, F.woutT, T, D, gc, F.bid);
        EpiOut E{F.x, F.x1};
        pg8::gemm_phase<EpiOut, DenseSched, false>(F.lds, S, E, F.wave);
    } else conv_role(F, I_R2, I_R3, gc);
}
__device__ __forceinline__ ExpTab build_exptab(Frame& F, int TM, int lds_off);
__device__ __forceinline__ void ph_moe(Frame& F, int upflag) {
    asm volatile("" : "+s"(upflag));
    const bool up = upflag != 0;
    ExpTab X = build_exptab(F, 256, EXPTAB_OFF);
    MoeSched S{X, (const char*)(up ? F.x1q : F.hq), (const char*)(up ? F.wguQ : F.wdQ), F.sorted, up ? FF / 128 : D / 256, F.G, vcu_of(F), up};
    EpiMoe E{up, EpiUp{F.hq, F.b_gu, X}, EpiDown{F.ybuf, F.b_down, X}};
    pg8::gemm_phase<EpiMoe, MoeSched, true, MoeSched::KQ, true>(F.lds, S, E, F.wave);
}
__device__ __forceinline__ void ph_moe_up(Frame& F) { ph_moe(F, 1); }
__device__ __forceinline__ void ph_moe_down(Frame& F) { ph_moe(F, 0); }


namespace mx {
typedef short bf16x8 __attribute__((ext_vector_type(8)));
typedef float f32x16 __attribute__((ext_vector_type(16)));
typedef unsigned u32x2 __attribute__((ext_vector_type(2)));
typedef unsigned u32x4 __attribute__((ext_vector_type(4)));
constexpr float LOG2E = 1.4426950408889634f, LN2 = 0.6931471805599453f;
__device__ __forceinline__ unsigned offrw(unsigned row, unsigned byte) { return 272u * row + byte; }
__device__ __forceinline__ unsigned offtr(unsigned row, unsigned byte) { return 320u * row + 32u * ((row >> 3) & 1u) + byte; }
#define MX_TRRD(dst, base, imm) asm volatile("ds_read_b64_tr_b16 %0, %1 offset:%c2" : "=&v"(dst) : "v"(base), "i"(imm) : "memory")
__device__ __forceinline__ bf16x8 frag(u32x2 lo, u32x2 hi) { u32x4 v; v.x = lo.x; v.y = lo.y; v.z = hi.x; v.w = hi.y; return __builtin_bit_cast(bf16x8, v); }
#define MX_DPP(x, ctrl) __builtin_bit_cast(float, __builtin_amdgcn_mov_dpp(__builtin_bit_cast(int, (x)), (ctrl), 0xf, 0xf, true))
__device__ __forceinline__ float row16_sum(float x) { x += MX_DPP(x, 0xB1); x += MX_DPP(x, 0x4E); x += MX_DPP(x, 0x141); x += MX_DPP(x, 0x140); return x; }
__device__ __forceinline__ float softplus_fast(float z) { const float e = __builtin_amdgcn_exp2f(-fabsf(z) * LOG2E); return fmaxf(z, 0.f) + __builtin_amdgcn_logf(1.0f + e) * LN2; }

__device__ __forceinline__ void sb_unit(Frame& F, int unit) {
    const int lane = lane_now(), w = F.wave, tid = w * 64 + lane, hh = lane >> 5, ql = lane & 31;
    const int qb = unit & 7, h = (unit >> 3) & 7, b = unit >> 6;
    const int q0 = qb * 256, qw0 = q0 + 32 * w, tq = qw0 + ql;
    const bf16* base = F.proj + (size_t)(b * SEQ) * INW + h * HD;
    const unsigned lb = (unsigned)(size_t)F.lds;
    constexpr int SB_V = 0, SB_K = 40960, SB_VB = 20480, SB_KB = 17408;
    LAS int* flags = (LAS int*)(F.lds + 75776);
    bf16x8 qf[8];
#pragma unroll
    for (int s = 0; s < 8; ++s) qf[s] = *(const bf16x8*)(base + (size_t)tq * INW + C_SBQ + 16 * s + 8 * hh);
    f32x16 oacc[4];
#pragma unroll
    for (int c = 0; c < 4; ++c)
#pragma unroll
        for (int r = 0; r < 16; ++r) oacc[c][r] = 0.f;
    float carry = 0.f;
    const int kt0 = qb * 4 + 3;
    u32x4 pk[2], pv[2];
    const int srow = tid >> 4, sch = tid & 15;
#define SB_GLOAD(kt) do { _Pragma("unroll") for (int i = 0; i < 2; ++i) { const bf16* p = base + (size_t)(64 * (kt) + srow + 32 * i) * INW + 8 * sch; pk[i] = *(const u32x4*)(p + C_SBK); pv[i] = *(const u32x4*)(p + C_SBV); } } while (0)
#define SB_LSTORE(buf) do { _Pragma("unroll") for (int i = 0; i < 2; ++i) { *(LAS u32x4*)(F.lds + SB_K + (buf) * SB_KB + offrw(srow + 32 * i, 16 * sch)) = pk[i]; *(LAS u32x4*)(F.lds + SB_V + (buf) * SB_VB + offtr(srow + 32 * i, 16 * sch)) = pv[i]; } } while (0)
    __syncthreads();
    SB_GLOAD(kt0); SB_LSTORE(0);
    __syncthreads();
    bool wdone = false;
    const int tq4 = (lane & 15) >> 2, tp = lane & 3, tblk = (lane >> 4) & 1;
    const unsigned kl = 272u * ql + 16u * hh, vl = lb + 320u * (4 * hh + tq4) + 32u * tblk + 8u * tp;
    for (int kt = kt0; kt >= 0; --kt) {
        const int cur = (kt0 - kt) & 1;
        if (kt > 0) SB_GLOAD(kt - 1);
        if (!wdone) {
#pragma unroll 1
            for (int sb = 1; sb >= 0; --sb) {
                const int kmin = 64 * kt + 32 * sb;
                if (kmin >= qw0 + 31) continue;
                f32x16 z;
#pragma unroll
                for (int r = 0; r < 16; ++r) z[r] = 0.f;
#pragma unroll
                for (int s = 0; s < 8; ++s) { const bf16x8 a = *(const LAS bf16x8*)(F.lds + SB_K + cur * SB_KB + 272 * 32 * sb + kl + 32 * s); z = __builtin_amdgcn_mfma_f32_32x32x16_bf16(a, qf[s], z, 0, 0, 0); }
                float l[16], Gs[4], Go[4];
#pragma unroll
                for (int r = 0; r < 16; ++r) { const int key = kmin + 8 * (r >> 2) + 4 * hh + (r & 3); l[r] = (key < tq) ? -softplus_fast(z[r]) : 0.f; }
#pragma unroll
                for (int g = 0; g < 4; ++g) { Gs[g] = (l[4 * g] + l[4 * g + 1]) + (l[4 * g + 2] + l[4 * g + 3]); Go[g] = __shfl_xor(Gs[g], 32); }
                float accs = carry, wv[16];
#pragma unroll
                for (int g = 3; g >= 0; --g) {
                    const float bs = accs + (hh == 0 ? Go[g] : 0.f); float suf = 0.f;
#pragma unroll
                    for (int i = 3; i >= 0; --i) { const int r = 4 * g + i; const int key = kmin + 8 * g + 4 * hh + i;
                        const float lw = (z[r] + l[r]) + (bs + suf);
                        wv[r] = (key < tq) ? __builtin_amdgcn_exp2f(lw * LOG2E) : 0.f; suf += l[r]; }
                    accs += Gs[g] + Go[g];
                }
                carry = accs;
#pragma unroll
                for (int s2 = 0; s2 < 2; ++s2) {
                    u32x4 pw; pw.x = pg8::cvt_pk_bf16(wv[8 * s2 + 0], wv[8 * s2 + 1]); pw.y = pg8::cvt_pk_bf16(wv[8 * s2 + 2], wv[8 * s2 + 3]);
                    pw.z = pg8::cvt_pk_bf16(wv[8 * s2 + 4], wv[8 * s2 + 5]); pw.w = pg8::cvt_pk_bf16(wv[8 * s2 + 6], wv[8 * s2 + 7]);
                    const bf16x8 pb = __builtin_bit_cast(bf16x8, pw);
                    u32x2 t0[4], t1[4];
                    const unsigned vb = vl + SB_V + cur * SB_VB + 320 * 32 * sb;
#pragma unroll
                    for (int c = 0; c < 4; ++c) { MX_TRRD(t0[c], vb, 5120 * s2 + 64 * c); MX_TRRD(t1[c], vb, 5120 * s2 + 2560 + 32 + 64 * c); }
                    asm volatile("s_waitcnt lgkmcnt(0)" : "+v"(t0[0]), "+v"(t0[1]), "+v"(t0[2]), "+v"(t0[3]), "+v"(t1[0]), "+v"(t1[1]), "+v"(t1[2]), "+v"(t1[3]) :: "memory");
#pragma unroll
                    for (int c = 0; c < 4; ++c) oacc[c] = __builtin_amdgcn_mfma_f32_32x32x16_bf16(frag(t0[c], t1[c]), pb, oacc[c], 0, 0, 0);
                }
            }
            wdone = __all(carry < -104.0f) != 0;
        }
        if (kt > 0) SB_LSTORE(cur ^ 1);
        if (lane == 0) flags[(kt & 1) * 8 + w] = wdone ? 1 : 0;
        __syncthreads();
        int all = 1;
#pragma unroll
        for (int i = 0; i < 8; ++i) all &= flags[(kt & 1) * 8 + i];
        if (all) break;
    }
#undef SB_GLOAD
#undef SB_LSTORE
    bf16* orow = F.mixin + (size_t)(b * SEQ + tq) * D + h * HD;
#pragma unroll
    for (int c = 0; c < 4; ++c)
#pragma unroll
        for (int g4 = 0; g4 < 4; ++g4) { u32x2 o; o.x = pg8::cvt_pk_bf16(oacc[c][4 * g4], oacc[c][4 * g4 + 1]); o.y = pg8::cvt_pk_bf16(oacc[c][4 * g4 + 2], oacc[c][4 * g4 + 3]);
            *(u32x2*)(orow + 32 * c + 8 * g4 + 4 * hh) = o; }
}

constexpr int R_KD = 0, R_VT = 20480, R_QT = 40960, R_KT = 58368, R_ST = 75776, R_PT = 110592, R_GNP = 119808, R_GNS = 123904, R_PPITCH = 144;
__device__ __forceinline__ void ret_unit(Frame& F, int unit) {
    const int lane = lane_now(), w = F.wave, tid = w * 64 + lane, g = lane >> 4, l15 = lane & 15;
    const int seg = unit & 7, h = (unit >> 3) & 7, b = unit >> 6;
    const float l2g = log1pf(-exp2f(-5.0f - (float)h)) * LOG2E;
    const float cd = exp2f(64.0f * l2g);
    const bf16* base = F.proj + (size_t)(b * SEQ) * INW + h * HD;
    const unsigned lb = (unsigned)(size_t)F.lds;
    LAS unsigned char* L = F.lds;
    LAS float* gnp = (LAS float*)(L + R_GNP); LAS float* gns = (LAS float*)(L + R_GNS);
    f32x4 st[8];
#pragma unroll
    for (int dt = 0; dt < 8; ++dt) st[dt] = (f32x4){0.f, 0.f, 0.f, 0.f};
    const int srow = tid >> 4, sch = tid & 15;
    float kdec[2];
#pragma unroll
    for (int i = 0; i < 2; ++i) kdec[i] = exp2f((float)(63 - (srow + 32 * i)) * l2g);
    u32x4 rq[2], rk[2], rv[2];
#define RT_GLOAD(n) do { _Pragma("unroll") for (int i = 0; i < 2; ++i) { const bf16* p = base + (size_t)(64 * (n) + srow + 32 * i) * INW + 8 * sch; \
        rq[i] = *(const u32x4*)(p + C_RQ); rk[i] = *(const u32x4*)(p + C_RK); rv[i] = *(const u32x4*)(p + C_RV); } } while (0)
    const int n_first = 4 * seg, n_end = 4 * seg + 4;
    const int tq4 = l15 >> 2, tp = lane & 3;
    const unsigned trl = lb + 320u * (8 * g + tq4) + 32u * (g & 1) + 8u * tp, trv = trl + R_VT + 32u * w;
    const unsigned rwl = 272u * l15 + 16u * g;
#define RT_IMM(c, ks, t) (10240 * (ks) + 1280 * (t) + 32 * (c))
#define RT_UPDATE(bufoff) do { _Pragma("unroll") for (int dt = 0; dt < 8; ++dt) st[dt] = st[dt] * cd; \
        _Pragma("unroll") for (int ks = 0; ks < 2; ++ks) { \
            u32x2 v0, v1; MX_TRRD(v0, trv, (bufoff) + RT_IMM(0, ks, 0)); MX_TRRD(v1, trv, (bufoff) + RT_IMM(0, ks, 1)); \
            u32x2 k0[8], k1[8]; \
            _Pragma("unroll") for (int dt = 0; dt < 8; ++dt) { MX_TRRD(k0[dt], trl, (bufoff) + R_KD + RT_IMM(dt, ks, 0)); MX_TRRD(k1[dt], trl, (bufoff) + R_KD + RT_IMM(dt, ks, 1)); } \
            asm volatile("s_waitcnt lgkmcnt(0)" : "+v"(v0), "+v"(v1), "+v"(k0[0]), "+v"(k0[1]), "+v"(k0[2]), "+v"(k0[3]), "+v"(k0[4]), "+v"(k0[5]), "+v"(k0[6]), "+v"(k0[7]), \
                         "+v"(k1[0]), "+v"(k1[1]), "+v"(k1[2]), "+v"(k1[3]), "+v"(k1[4]), "+v"(k1[5]), "+v"(k1[6]), "+v"(k1[7]) :: "memory"); \
            const bf16x8 vb = frag(v0, v1); \
            _Pragma("unroll") for (int dt = 0; dt < 8; ++dt) st[dt] = __builtin_amdgcn_mfma_f32_16x16x32_bf16(frag(k0[dt], k1[dt]), vb, st[dt], 0, 0, 0); } } while (0)
#define RT_KDPACK(dst, src, kdv) do { dst.x = pg8::cvt_pk_bf16(bf2f(src.x & 0xffffu) * kdv, bf2f(src.x >> 16) * kdv); dst.y = pg8::cvt_pk_bf16(bf2f(src.y & 0xffffu) * kdv, bf2f(src.y >> 16) * kdv); \
        dst.z = pg8::cvt_pk_bf16(bf2f(src.z & 0xffffu) * kdv, bf2f(src.z >> 16) * kdv); dst.w = pg8::cvt_pk_bf16(bf2f(src.w & 0xffffu) * kdv, bf2f(src.w >> 16) * kdv); } while (0)
    RT_GLOAD(n_first);
    if (n_first > 0) {
        u32x4 pk0[2], pv0[2], pk1[2], pv1[2];
#define RT_PLOAD(PK, PV, n) do { _Pragma("unroll") for (int i = 0; i < 2; ++i) { const bf16* p = base + (size_t)(64 * (n) + srow + 32 * i) * INW + 8 * sch; PK[i] = *(const u32x4*)(p + C_RK); PV[i] = *(const u32x4*)(p + C_RV); } } while (0)
#define RT_PSTORE(PK, PV, bufoff) do { _Pragma("unroll") for (int i = 0; i < 2; ++i) { const unsigned ot = offtr(srow + 32 * i, 16 * sch); *(LAS u32x4*)(L + (bufoff) + R_VT + ot) = PV[i]; \
            u32x4 kd; const float kdv = kdec[i]; RT_KDPACK(kd, PK[i], kdv); *(LAS u32x4*)(L + (bufoff) + R_KD + ot) = kd; } } while (0)
        RT_PLOAD(pk0, pv0, 0); RT_PLOAD(pk1, pv1, 1);
        __syncthreads();
        for (int n = 0; n < n_first; n += 2) {
            RT_PSTORE(pk0, pv0, 0); if (n + 2 < n_first) RT_PLOAD(pk0, pv0, n + 2);
            __syncthreads();
            RT_UPDATE(0);
            RT_PSTORE(pk1, pv1, 40960); if (n + 3 < n_first) RT_PLOAD(pk1, pv1, n + 3);
            __syncthreads();
            RT_UPDATE(40960);
        }
#undef RT_PLOAD
#undef RT_PSTORE
    }
    for (int n = n_first; n < n_end; ++n) {
        constexpr bool full = true;
        __syncthreads();
#pragma unroll
        for (int i = 0; i < 2; ++i) {
            const unsigned o = offrw(srow + 32 * i, 16 * sch), ot = offtr(srow + 32 * i, 16 * sch);
            *(LAS u32x4*)(L + R_QT + o) = rq[i]; *(LAS u32x4*)(L + R_KT + o) = rk[i]; *(LAS u32x4*)(L + R_VT + ot) = rv[i];
            u32x4 kd; const float kdv = kdec[i]; RT_KDPACK(kd, rk[i], kdv);
            *(LAS u32x4*)(L + R_KD + ot) = kd;
        }
        if (full) {
#pragma unroll
            for (int dt = 0; dt < 8; ++dt) { u32x2 o; o.x = pg8::cvt_pk_bf16(st[dt][0], st[dt][1]); o.y = pg8::cvt_pk_bf16(st[dt][2], st[dt][3]);
                *(LAS u32x2*)(L + R_ST + offrw(16 * w + l15, 32 * dt + 8 * g)) = o; }
        }
        if (n + 1 < n_end) RT_GLOAD(n + 1);
        unsigned short gq[4][4];
#pragma unroll
        for (int mt = 0; mt < 4; ++mt)
#pragma unroll
            for (int r = 0; r < 4; ++r) gq[mt][r] = base[(size_t)(64 * n + 16 * mt + 4 * g + r) * INW + C_RG + 16 * w + l15];
        __syncthreads();
        if (full) {
            {
                const int jt = w & 3, ctb = 2 * (w >> 2);
                f32x4 sc[2] = {(f32x4){0.f, 0.f, 0.f, 0.f}, (f32x4){0.f, 0.f, 0.f, 0.f}};
#pragma unroll
                for (int s = 0; s < 4; ++s) { const bf16x8 a = *(const LAS bf16x8*)(L + R_KT + 4352 * jt + rwl + 64 * s);
#pragma unroll
                    for (int cc = 0; cc < 2; ++cc) { const bf16x8 bq = *(const LAS bf16x8*)(L + R_QT + 4352 * (ctb + cc) + rwl + 64 * s); sc[cc] = __builtin_amdgcn_mfma_f32_16x16x32_bf16(a, bq, sc[cc], 0, 0, 0); } }
#pragma unroll
                for (int cc = 0; cc < 2; ++cc) { const int c = 16 * (ctb + cc) + l15, j0 = 16 * jt + 4 * g; float pvv[4];
#pragma unroll
                    for (int r = 0; r < 4; ++r) pvv[r] = sc[cc][r] * __builtin_amdgcn_exp2f(fabsf((float)(c - (j0 + r))) * l2g);
                    u32x2 o; o.x = pg8::cvt_pk_bf16(pvv[0], pvv[1]); o.y = pg8::cvt_pk_bf16(pvv[2], pvv[3]);
                    *(LAS u32x2*)(L + R_PT + c * R_PPITCH + j0 * 2) = o; }
            }
            __syncthreads();
            f32x4 oi[4], oc[4];
#pragma unroll
            for (int mt = 0; mt < 4; ++mt) { oi[mt] = (f32x4){0.f, 0.f, 0.f, 0.f}; oc[mt] = (f32x4){0.f, 0.f, 0.f, 0.f}; }
#pragma unroll
            for (int s = 0; s < 2; ++s) {
                u32x2 v0, v1; MX_TRRD(v0, trv, RT_IMM(0, s, 0)); MX_TRRD(v1, trv, RT_IMM(0, s, 1));
                asm volatile("s_waitcnt lgkmcnt(0)" : "+v"(v0), "+v"(v1) :: "memory");
                const bf16x8 vb = frag(v0, v1);
#pragma unroll
                for (int mt = 0; mt < 4; ++mt) { const bf16x8 pa = *(const LAS bf16x8*)(L + R_PT + (l15 + 16 * mt) * R_PPITCH + (32 * s + 8 * g) * 2); oi[mt] = __builtin_amdgcn_mfma_f32_16x16x32_bf16(pa, vb, oi[mt], 0, 0, 0); }
            }
#pragma unroll
            for (int s = 0; s < 4; ++s) {
                const bf16x8 sb_ = *(const LAS bf16x8*)(L + R_ST + 4352 * w + rwl + 64 * s);
#pragma unroll
                for (int mt = 0; mt < 4; ++mt) { const bf16x8 qa = *(const LAS bf16x8*)(L + R_QT + 4352 * mt + rwl + 64 * s); oc[mt] = __builtin_amdgcn_mfma_f32_16x16x32_bf16(qa, sb_, oc[mt], 0, 0, 0); }
            }
#pragma unroll
            for (int mt = 0; mt < 4; ++mt)
#pragma unroll
                for (int r = 0; r < 4; ++r) { const int c = 16 * mt + 4 * g + r; const float o = oi[mt][r] + __builtin_amdgcn_exp2f((float)(c + 1) * l2g) * oc[mt][r]; oi[mt][r] = o;
                    const float s1 = row16_sum(o), s2 = row16_sum(o * o);
                    if (l15 == 0) { gnp[(c * 8 + w) * 2] = s1; gnp[(c * 8 + w) * 2 + 1] = s2; } }
            __syncthreads();
            if (tid < 64) { float s1 = 0.f, s2 = 0.f;
#pragma unroll
                for (int ww = 0; ww < 8; ++ww) { s1 += gnp[(tid * 8 + ww) * 2]; s2 += gnp[(tid * 8 + ww) * 2 + 1]; }
                const float mu = s1 * (1.0f / 128.0f), var = fmaxf(s2 * (1.0f / 128.0f) - mu * mu, 0.f);
                gns[tid * 2] = mu; gns[tid * 2 + 1] = 1.0f / sqrtf(var + GN_EPS); }
            __syncthreads();
            {   const int e = 16 * w + l15; const float gain = F.gn_gain[h * HD + e];
#pragma unroll
                for (int mt = 0; mt < 4; ++mt)
#pragma unroll
                    for (int r = 0; r < 4; ++r) { const int c = 16 * mt + 4 * g + r; const size_t row = (size_t)(b * SEQ + 64 * n + c);
                        const float gv = bf2f(gq[mt][r]);
                        const float y = (oi[mt][r] - gns[c * 2]) * gns[c * 2 + 1] * gain * (gv * __builtin_amdgcn_rcpf(1.0f + __builtin_amdgcn_exp2f(-gv * LOG2E)));
                        F.mixin[row * D + 1024 + h * HD + e] = (bf16)f2bf(y); }
            }
        }
        RT_UPDATE(0);
    }
#undef RT_GLOAD
#undef RT_IMM
#undef RT_UPDATE
#undef RT_KDPACK
}
}

__device__ __forceinline__ void ph_mixer(Frame& F) {
    const int gc = role_split(F) ? W_MIX : F.G;
    if (F.bid < gc) {
        for (int u = F.bid; u < NB * NH * 8; u += gc) mx::ret_unit(F, u);
        for (int u = F.bid; u < NB * NH * 8; u += gc) mx::sb_unit(F, u ^ 7);
    } else conv_role(F, I_R1, I_R2, gc);
}

__device__ __forceinline__ void ln_row(float4 (&v)[8], const float* gain, const float* bias, int lane) {
    float s = 0.f;
#pragma unroll
    for (int j = 0; j < 8; ++j) s += (v[j].x + v[j].y) + (v[j].z + v[j].w);
    const float mean = wave_sum(s) * (1.0f / D);
    float q = 0.f;
#pragma unroll
    for (int j = 0; j < 8; ++j) { v[j].x -= mean; v[j].y -= mean; v[j].z -= mean; v[j].w -= mean; q += (v[j].x * v[j].x + v[j].y * v[j].y) + (v[j].z * v[j].z + v[j].w * v[j].w); }
    const float rstd = 1.0f / sqrtf(wave_sum(q) * (1.0f / D) + LN_EPS);
#pragma unroll
    for (int j = 0; j < 8; ++j) { const float4 g = *(const float4*)(gain + 4 * lane + 256 * j), bb = *(const float4*)(bias + 4 * lane + 256 * j);
        v[j].x = v[j].x * rstd * g.x + bb.x; v[j].y = v[j].y * rstd * g.y + bb.y; v[j].z = v[j].z * rstd * g.z + bb.z; v[j].w = v[j].w * rstd * g.w + bb.w; }
}


constexpr int XT_PITCH = 2052;
constexpr int RPART_OFF = 134144, RLOG_OFF = 150528;
__device__ __forceinline__ void ph_ln1_router(Frame& F) {
    LAS float* xt = (LAS float*)F.lds;
    LAS float* part = (LAS float*)(F.lds + RPART_OFF);
    LAS float* lgt = (LAS float*)(F.lds + RLOG_OFF);
    const int lane = F.lane, w = F.wave;
    const float* bp = F.w_router + (size_t)(256 * w + (lane >> 4)) * NE + (lane & 15);
    f32x4 va[8], vb[8];
#define LN1_ISSUE(uu) do { const f32x4* xr0 = (const f32x4*)(F.x1 + (size_t)((uu) * 16 + 2 * w) * D) + lane; const f32x4* xr1 = xr0 + D / 4; \
        _Pragma("unroll") for (int j = 0; j < 8; ++j) { va[j] = xr0[64 * j]; vb[j] = xr1[64 * j]; } } while (0)
    const int gc = role_split(F) ? W_LN1 : F.G;
    if (F.bid >= gc) { conv_role(F, I_R3, I_ALL, gc); return; }
    int u = F.bid;
    if (u < T / 16) LN1_ISSUE(u);
    for (; u < T / 16; u += gc) {
        const int m0 = u * 16;
        __syncthreads();
        {
            float sa = 0.f, sb = 0.f;
#pragma unroll
            for (int j = 0; j < 8; ++j) { sa += (va[j][0] + va[j][1]) + (va[j][2] + va[j][3]); sb += (vb[j][0] + vb[j][1]) + (vb[j][2] + vb[j][3]); }
            const float ma = wave_sum(sa) * (1.0f / D), mb = wave_sum(sb) * (1.0f / D);
            float qa = 0.f, qb = 0.f;
#pragma unroll
            for (int j = 0; j < 8; ++j) { va[j] = va[j] - ma; vb[j] = vb[j] - mb; const f32x4 a2 = va[j] * va[j], b2 = vb[j] * vb[j]; qa += (a2[0] + a2[1]) + (a2[2] + a2[3]); qb += (b2[0] + b2[1]) + (b2[2] + b2[3]); }
            const float ra = 1.0f / sqrtf(wave_sum(qa) * (1.0f / D) + LN_EPS), rb = 1.0f / sqrtf(wave_sum(qb) * (1.0f / D) + LN_EPS);
            unsigned* ob0 = (unsigned*)(F.x1q + (size_t)(m0 + 2 * w) * D) + lane; unsigned* ob1 = ob0 + D / 4;
            pg8::u32x2* oh0 = (pg8::u32x2*)(F.x1h + (size_t)(m0 + 2 * w) * D) + lane; pg8::u32x2* oh1 = oh0 + D / 4;
#pragma unroll
            for (int j = 0; j < 8; ++j) {
                const f32x4 gj = *(const f32x4*)(F.ln1_g + 4 * lane + 256 * j), bj = *(const f32x4*)(F.ln1_b + 4 * lane + 256 * j);
                const f32x4 ya = va[j] * ra * gj + bj, yb = vb[j] * rb * gj + bj;
                { pg8::u32x2 ha, hb; ha.x = pg8::cvt_pk_bf16(ya[0], ya[1]); ha.y = pg8::cvt_pk_bf16(ya[2], ya[3]); hb.x = pg8::cvt_pk_bf16(yb[0], yb[1]); hb.y = pg8::cvt_pk_bf16(yb[2], yb[3]); oh0[64 * j] = ha; oh1[64 * j] = hb; }
                int o = __builtin_amdgcn_cvt_pk_fp8_f32(ya[0], ya[1], 0, false); o = __builtin_amdgcn_cvt_pk_fp8_f32(ya[2], ya[3], o, true); ob0[64 * j] = (unsigned)o;
                o = __builtin_amdgcn_cvt_pk_fp8_f32(yb[0], yb[1], 0, false); o = __builtin_amdgcn_cvt_pk_fp8_f32(yb[2], yb[3], o, true); ob1[64 * j] = (unsigned)o;
                *(LAS f32x4*)(xt + (2 * w) * XT_PITCH + 4 * lane + 256 * j) = ya; *(LAS f32x4*)(xt + (2 * w + 1) * XT_PITCH + 4 * lane + 256 * j) = yb; }
        }
        {
            float rb0[64], rb1[64];
            __builtin_amdgcn_sched_barrier(0);
            const float* bq = bp; asm volatile("" : "+v"(bq));
#pragma unroll
            for (int ks = 0; ks < 64; ++ks) { rb0[ks] = bq[(size_t)(4 * ks) * NE]; rb1[ks] = bq[(size_t)(4 * ks) * NE + 16]; }
            __syncthreads();
            f32x4 c0 = {0.f, 0.f, 0.f, 0.f}, c1 = {0.f, 0.f, 0.f, 0.f};
            const LAS float* ap = xt + (lane & 15) * XT_PITCH + 256 * w + (lane >> 4);
#pragma unroll
            for (int ks = 0; ks < 64; ++ks) {
                const float a = ap[4 * ks];
                c0 = __builtin_amdgcn_mfma_f32_16x16x4f32(a, rb0[ks], c0, 0, 0, 0);
                c1 = __builtin_amdgcn_mfma_f32_16x16x4f32(a, rb1[ks], c1, 0, 0, 0);
                if ((ks & 7) == 7) __builtin_amdgcn_sched_barrier(0);
            }
            __builtin_amdgcn_sched_barrier(0);
            if (u + gc < T / 16) LN1_ISSUE(u + gc);
#pragma unroll
            for (int g = 0; g < 4; ++g) { part[(w * 16 + 4 * (lane >> 4) + g) * 32 + (lane & 15)] = c0[g]; part[(w * 16 + 4 * (lane >> 4) + g) * 32 + 16 + (lane & 15)] = c1[g]; }
        }
        __syncthreads();
        {   const int r = F.tid >> 5, e = F.tid & 31; float s = F.b_router[e];
#pragma unroll
            for (int ww = 0; ww < 8; ++ww) s += part[(ww * 16 + r) * 32 + e];
            lgt[r * 33 + e] = s; }
        __syncthreads();
        if (F.tid < 16) {
            const LAS float* lg = lgt + F.tid * 33; const int t = m0 + F.tid;
            int i0 = -1, i1 = -1, i2 = -1, i3 = -1; float v0 = 0.f, v1 = 0.f, v2 = 0.f, v3 = 0.f;
#pragma unroll 1
            for (int k = 0; k < TOPK; ++k) {
                float best = -3.0e38f; int bi = 0;
                for (int e = 0; e < NE; ++e) { const float v = lg[e]; const bool used = (e == i0) | (e == i1) | (e == i2); if (!used && v > best) { best = v; bi = e; } }
                if (k == 0) { i0 = bi; v0 = best; } else if (k == 1) { i1 = bi; v1 = best; } else if (k == 2) { i2 = bi; v2 = best; } else { i3 = bi; v3 = best; }
            }
            const float e0 = 1.0f, e1 = expf(v1 - v0), e2 = expf(v2 - v0), e3 = expf(v3 - v0), inv = 1.0f / (e0 + e1 + e2 + e3);
            const int p0 = (int)atomicAdd(F.ctl + CW_CNT + i0, 1u), p1 = (int)atomicAdd(F.ctl + CW_CNT + i1, 1u), p2 = (int)atomicAdd(F.ctl + CW_CNT + i2, 1u), p3 = (int)atomicAdd(F.ctl + CW_CNT + i3, 1u);
            *(int4*)(F.toke + (size_t)t * 4) = make_int4(i0, i1, i2, i3);
            *(int4*)(F.tokp + (size_t)t * 4) = make_int4(p0, p1, p2, p3);
            *(float4*)(F.tokg + (size_t)t * 4) = make_float4(e0 * inv, e1 * inv, e2 * inv, e3 * inv);
            F.sorted[(size_t)i0 * T + p0] = t; F.sorted[(size_t)i1 * T + p1] = t; F.sorted[(size_t)i2 * T + p2] = t; F.sorted[(size_t)i3 * T + p3] = t;
        }
    }
}
#undef LN1_ISSUE

__device__ __forceinline__ ExpTab build_exptab(Frame& F, int TM, int lds_off) {
    ExpTab X; X.cnt = (LAS int*)(F.lds + lds_off); X.off = X.cnt + 32; X.tpre = X.off + 32;
    __syncthreads();
    if (F.wave == 0) {
        const int lane = F.lane;
        const int c = lane < NE ? (int)__hip_atomic_load(F.ctl + CW_CNT + lane, __ATOMIC_RELAXED, __HIP_MEMORY_SCOPE_AGENT) : 0;
        int so = c, st = (c + TM - 1) / TM; const int t0 = st;
#pragma unroll
        for (int d = 1; d < 32; d <<= 1) { const int a = __shfl_up(so, d), bq = __shfl_up(st, d); if (lane >= d) { so += a; st += bq; } }
        if (lane < NE) { X.cnt[lane] = c; X.off[lane] = so - c; X.tpre[lane] = st - t0; }
        if (lane == NE - 1) X.tpre[NE] = st;
    }
    __syncthreads();
    return X;
}

struct FinMeta { const pg8::u32x2 *y0, *y1, *y2, *y3, *xr; float4 tg; };
struct FinRaw { pg8::u32x2 x[4], a[4], b[4], c[4], d[4]; };
__device__ __forceinline__ void ph_final(Frame& F) {
    ExpTab X = build_exptab(F, 256, EXPTAB_OFF);
    LAS float* gl = (LAS float*)F.lds; LAS float* bl = gl + D;
    for (int i = F.tid; i < D; i += NTHREADS) { gl[i] = F.ln2_g[i]; bl[i] = F.ln2_b[i]; }
    __syncthreads();
    const int gw = F.bid * NWAVES + F.wave, NGW = F.G * NWAVES, lane = F.lane;
#define FIN_META(M, m) do { const int4 te = *(const int4*)(F.toke + (size_t)(m) * 4), tp = *(const int4*)(F.tokp + (size_t)(m) * 4); M.tg = *(const float4*)(F.tokg + (size_t)(m) * 4); \
        M.y0 = (const pg8::u32x2*)(F.ybuf + (size_t)(X.off[te.x] + tp.x) * D) + lane; M.y1 = (const pg8::u32x2*)(F.ybuf + (size_t)(X.off[te.y] + tp.y) * D) + lane; \
        M.y2 = (const pg8::u32x2*)(F.ybuf + (size_t)(X.off[te.z] + tp.z) * D) + lane; M.y3 = (const pg8::u32x2*)(F.ybuf + (size_t)(X.off[te.w] + tp.w) * D) + lane; M.xr = (const pg8::u32x2*)(F.x1h + (size_t)(m) * D) + lane; } while (0)
#define FIN_LOAD(R, M, hf) do { _Pragma("unroll") for (int j = 0; j < 4; ++j) { R.x[j] = __builtin_nontemporal_load(M.xr + 64 * (4 * (hf) + j)); R.a[j] = __builtin_nontemporal_load(M.y0 + 64 * (4 * (hf) + j)); R.b[j] = __builtin_nontemporal_load(M.y1 + 64 * (4 * (hf) + j)); R.c[j] = __builtin_nontemporal_load(M.y2 + 64 * (4 * (hf) + j)); R.d[j] = __builtin_nontemporal_load(M.y3 + 64 * (4 * (hf) + j)); } } while (0)
#define FIN_COMB(R, M, hf) do { _Pragma("unroll") for (int j = 0; j < 4; ++j) { const pg8::u32x2 xh = R.x[j]; const float4 xv = make_float4(bf2f(xh.x & 0xffffu), bf2f(xh.x >> 16), bf2f(xh.y & 0xffffu), bf2f(xh.y >> 16)); const pg8::u32x2 a = R.a[j], b = R.b[j], c = R.c[j], d = R.d[j]; const float4 tg = M.tg; float4 o; \
        o.x = ALPHA * xv.x + tg.x * bf2f(a.x & 0xffffu) + tg.y * bf2f(b.x & 0xffffu) + tg.z * bf2f(c.x & 0xffffu) + tg.w * bf2f(d.x & 0xffffu); \
        o.y = ALPHA * xv.y + tg.x * bf2f(a.x >> 16) + tg.y * bf2f(b.x >> 16) + tg.z * bf2f(c.x >> 16) + tg.w * bf2f(d.x >> 16); \
        o.z = ALPHA * xv.z + tg.x * bf2f(a.y & 0xffffu) + tg.y * bf2f(b.y & 0xffffu) + tg.z * bf2f(c.y & 0xffffu) + tg.w * bf2f(d.y & 0xffffu); \
        o.w = ALPHA * xv.w + tg.x * bf2f(a.y >> 16) + tg.y * bf2f(b.y >> 16) + tg.z * bf2f(c.y >> 16) + tg.w * bf2f(d.y >> 16); v[4 * (hf) + j] = o; } } while (0)
    int m = gw; if (m >= T) return;
    FinMeta Mc, Mn; FinRaw A, B; float4 v[8];
    FIN_META(Mc, m); FIN_LOAD(A, Mc, 0);
    for (; m < T; m += NGW) {
        FIN_LOAD(B, Mc, 1);
        FIN_COMB(A, Mc, 0);
        const int mn = m + NGW; const bool more = mn < T;
        if (more) { FIN_META(Mn, mn); FIN_LOAD(A, Mn, 0); }
        FIN_COMB(B, Mc, 1);
        float s = 0.f;
#pragma unroll
        for (int j = 0; j < 8; ++j) s += (v[j].x + v[j].y) + (v[j].z + v[j].w);
        const float mean = wave_sum(s) * (1.0f / D);
        float q = 0.f;
#pragma unroll
        for (int j = 0; j < 8; ++j) { v[j].x -= mean; v[j].y -= mean; v[j].z -= mean; v[j].w -= mean; q += (v[j].x * v[j].x + v[j].y * v[j].y) + (v[j].z * v[j].z + v[j].w * v[j].w); }
        const float rstd = 1.0f / sqrtf(wave_sum(q) * (1.0f / D) + LN_EPS);
        f32x4* o = (f32x4*)(F.out + (size_t)m * D) + lane;
#pragma unroll
        for (int j = 0; j < 8; ++j) { const f32x4 g = *(const LAS f32x4*)(gl + 4 * lane + 256 * j), bb = *(const LAS f32x4*)(bl + 4 * lane + 256 * j);
            __builtin_nontemporal_store((f32x4){v[j].x * rstd * g[0] + bb[0], v[j].y * rstd * g[1] + bb[1], v[j].z * rstd * g[2] + bb[2], v[j].w * rstd * g[3] + bb[3]}, o + 64 * j); }
        Mc = Mn;
    }
#undef FIN_META
#undef FIN_LOAD
#undef FIN_COMB
}

constexpr int LDS_BYTES = 155648;
constexpr int MISC_OFF = 132096;

__global__ void __launch_bounds__(NTHREADS, 2) fwd(Args args) {
    extern __shared__ __attribute__((aligned(16))) unsigned char lds[];
    Frame F;
    F.lds = (LAS unsigned char*)lds;
    F.tid = threadIdx.x; F.lane = F.tid & 63; F.wave = __builtin_amdgcn_readfirstlane(F.tid >> 6);
    F.G = gridDim.x; F.bid = blockIdx.x;
    unsigned char* ws = args.ws;
    F.x = args.in[0]; F.w_in = args.in[1]; F.gn_gain = args.in[2]; F.w_out = args.in[3]; F.ln1_g = args.in[4]; F.ln1_b = args.in[5];
    F.w_router = args.in[6]; F.b_router = args.in[7]; F.w_gu = args.in[8]; F.b_gu = args.in[9]; F.w_down = args.in[10]; F.b_down = args.in[11];
    F.ln2_g = args.in[12]; F.ln2_b = args.in[13]; F.out = args.out;
    F.ctl = (unsigned*)(ws + WS_CTL);
    F.ropec = (float*)(ws + WS_ROPE); F.ropes = F.ropec + SEQ * 64;
    F.xb = (bf16*)(ws + WS_XB); F.proj = (bf16*)(ws + WS_PROJ); F.mixin = (bf16*)(ws + WS_MIXIN); F.x1 = (float*)(ws + WS_X1); F.x1q = ws + WS_X1B; F.x1h = (bf16*)(ws + WS_X1H);
    F.logits = (float*)(ws + WS_LOGITS); F.toke = (int*)(ws + WS_TOKE); F.tokp = (int*)(ws + WS_TOKP); F.tokg = (float*)(ws + WS_TOKG); F.sorted = (int*)(ws + WS_SORTED);
    F.hq = ws + WS_H; F.ybuf = (bf16*)(ws + WS_Y);
    F.winT = (bf16*)(ws + WS_WIN_T); F.woutT = (bf16*)(ws + WS_WOUT_T); F.wguQ = ws + WS_WGU_T; F.wdQ = ws + WS_WD_T;

    volatile LAS unsigned* MISC = (volatile LAS unsigned*)(F.lds + MISC_OFF);
    if (F.tid < 32) MISC[F.tid] = 0u;
    __syncthreads();
    const int lo = args.ph_lo, hi = args.ph_hi;
    XcdBarrier bar; bar.bar = F.ctl + CW_BAR; bar.x = 0; bar.st = nullptr;
    if (hi - lo > 1) bar = xcd_barrier_post(F.ctl + CW_BAR, MISC + 8);
#define IN(k) (lo <= (k) && (k) < hi && ((F.lane = lane_now()), (F.tid = F.wave * 64 + F.lane), true))
#define SEAM(k) do { if (IN(k) && IN((k) + 1)) xcd_barrier(bar, F.wave == 0 && lane_now() == 0); } while (0)
    if (IN(0)) { ph_prologue(F); ph_prologue_w(F); }
    SEAM(0);
    if (IN(1)) ph_proj(F);
    SEAM(1);
    if (IN(2)) ph_mixer(F);
    SEAM(2);
    if (IN(3)) ph_outproj(F);
    SEAM(3);
    if (IN(4)) ph_ln1_router(F);
    SEAM(4);
    if (IN(5)) ph_moe_up(F);
    SEAM(5);
    if (IN(6)) ph_moe_down(F);
    SEAM(6);
    if (IN(7)) ph_final(F);
#undef IN
#undef SEAM
}
}

extern "C" void kernel_launch(void* const* d_in, const int* in_sizes, int n_in, void* d_out, int out_size, void* d_ws, size_t ws_size, hipStream_t stream) {
    static int grid = 0;
    if (grid == 0) {
        if (n_in != 14 || out_size != T * D || ws_size < WS_END) { fprintf(stderr, "kernel_launch: unexpected shapes (n_in %d out %d ws %zu)\n", n_in, out_size, ws_size); grid = -1; return; }
        int dev = 0, cus = 0, per_cu = 0;
        if (hipGetDevice(&dev) != hipSuccess || hipDeviceGetAttribute(&cus, hipDeviceAttributeMultiprocessorCount, dev) != hipSuccess) { grid = -1; return; }
        if (hipFuncSetAttribute((const void*)fwd, hipFuncAttributeMaxDynamicSharedMemorySize, LDS_BYTES) != hipSuccess) { fprintf(stderr, "kernel_launch: hipFuncSetAttribute failed\n"); grid = -1; return; }
        if (hipOccupancyMaxActiveBlocksPerMultiprocessor(&per_cu, (const void*)fwd, NTHREADS, LDS_BYTES) != hipSuccess || per_cu < 1) fprintf(stderr, "kernel_launch: occupancy query says %d\n", per_cu);
        (void)hipGetLastError();
        grid = cus;
    }
    if (grid < 0) return;
    (void)hipMemsetAsync((char*)d_ws + WS_CTL, 0, CTL_ZERO_BYTES, stream);
    Args a{};
    for (int i = 0; i < 14; ++i) a.in[i] = (const float*)d_in[i];
    a.out = (float*)d_out; a.ws = (unsigned char*)d_ws;
    constexpr int NL = MK_N_LAUNCHES;
    for (int li = 0; li < NL; ++li) {
        a.ph_lo = (NL == 1) ? 0 : li; a.ph_hi = (NL == 1) ? NPHASE : li + 1;
        hipLaunchKernelGGL(fwd, dim3(grid), dim3(NTHREADS), LDS_BYTES, stream, a);
    }
}
```
